# Optimizing an MI355X kernel written in HIP

```python
import jax, jax.numpy as jnp
from jax import lax
import numpy as np

D_MODEL = 1024
BATCH = 2
SEQ = 8192
DEPTH = 4

GRID_W = 64
CTX_LEN = 256

DEEPNORM_ALPHA = (2 * DEPTH) ** 0.25
DEEPNORM_BETA = (8 * DEPTH) ** -0.25
LN_EPS = 1e-6

N_EVEN = (DEPTH + 1) // 2
N_ODD = DEPTH // 2

GLA_HEADS = 4
GLA_DK = 64
GLA_DV = 128
GLA_QK_W = GLA_HEADS * GLA_DK
GLA_V_W = GLA_HEADS * GLA_DV
GLA_GATE_RANK = 16
GLA_TAU = 16.0
GLA_CHUNK = 64

MLA_HEADS = 8
MLA_NOPE = 64
MLA_ROPE = 32
MLA_V = 64
MLA_Q_RANK = 256
MLA_KV_RANK = 128
MLA_V_W = MLA_HEADS * MLA_V
MLA_SCALE = (MLA_NOPE + MLA_ROPE) ** -0.5
ROPE_BASE = 10000.0
Q_BLOCK = 128

FNET_GROUPS = 4
FNET_GROUP_CH = 128
FNET_W = FNET_GROUPS * FNET_GROUP_CH

SGU_GROUPS = 4
SGU_GROUP_CH = 128
SGU_W = SGU_GROUPS * SGU_GROUP_CH
SGU_CHUNK = 128

EVEN_IN_SIZES = (GLA_QK_W, GLA_QK_W, GLA_V_W, 2 * GLA_GATE_RANK, GLA_V_W,
                 MLA_Q_RANK, MLA_KV_RANK, MLA_ROPE, MLA_V_W)
ODD_IN_SIZES = (FNET_W, FNET_W, SGU_W, SGU_W, SGU_W)
EVEN_OUT_IN = GLA_V_W + MLA_V_W
ODD_OUT_IN = FNET_W + SGU_W

kernel_name = "hybrid_gla_mla_fnet_sgu_prefix_dit"


def split_cols(z, sizes):
    idx = np.cumsum(sizes)[:-1].tolist()
    return jnp.split(z, idx, axis=-1)


def layer_norm(x, g=None, b=None):
    xf = x.astype(jnp.float32)
    xc = xf - jnp.mean(xf, -1, keepdims=True)
    y = xc * lax.rsqrt(jnp.mean(xc * xc, -1, keepdims=True) + LN_EPS)
    if g is not None:
        y = y * g.astype(jnp.float32) + b.astype(jnp.float32)
    return y.astype(x.dtype)


def rms_norm(x, g):
    xf = x.astype(jnp.float32)
    y = xf * lax.rsqrt(jnp.mean(xf * xf, -1, keepdims=True) + LN_EPS)
    return (y * g.astype(jnp.float32)).astype(x.dtype)


def ada_mod(cond, w, b):
    m = jnp.dot(jax.nn.silu(cond), w) + b
    return jnp.split(m, 3, axis=-1)


def modulate(x, shift, scale):
    return layer_norm(x) * (1 + scale[..., None, :]) + shift[..., None, :]


def axial_rope_angles(n):
    rows = n // GRID_W
    row = jnp.repeat(jnp.arange(rows, dtype=jnp.float32), GRID_W)
    col = (jnp.arange(n) % GRID_W).astype(jnp.float32)
    n_freq = MLA_ROPE // 4
    inv = ROPE_BASE ** (-jnp.arange(n_freq, dtype=jnp.float32) / n_freq)
    ang = jnp.concatenate([row[:, None] * inv, col[:, None] * inv], -1)
    return jnp.cos(ang), jnp.sin(ang)


def apply_rope(x, cos, sin):
    xf = x.astype(jnp.float32)
    x1, x2 = jnp.split(xf, 2, axis=-1)
    return jnp.concatenate([x1 * cos - x2 * sin, x1 * sin + x2 * cos], -1).astype(x.dtype)


def gla_q(q):
    B, n, _ = q.shape
    return q.astype(jnp.float32).reshape(B, n, GLA_HEADS, GLA_DK) * GLA_DK ** -0.5


def gla_kvg(k, v, lr, w2, b):
    B, n, _ = k.shape
    heads = lambda a, d: a.astype(jnp.float32).reshape(B, n, GLA_HEADS, d)
    lr_dirs = jnp.split(lr.astype(jnp.float32), 2, axis=-1)
    g = tuple(
        heads(jax.nn.log_sigmoid(jnp.einsum('bnr,re->bne', lr_dirs[d], w2[d].astype(jnp.float32))
                                 + b[d].astype(jnp.float32)) / GLA_TAU, GLA_DK)
        for d in range(2))
    return heads(k, GLA_DK), heads(v, GLA_DV), g


def gla_chunk_scan(q, k, v, g, s0):
    B, n, H, _ = q.shape
    nc = n // GLA_CHUNK
    chunk = lambda a: a.reshape(B, nc, GLA_CHUNK, H, a.shape[-1])
    q, k, v, g = chunk(q), chunk(k), chunk(v), chunk(g)
    b = jnp.cumsum(g, axis=2)
    b_mid = b[:, :, GLA_CHUNK // 2 - 1:GLA_CHUNK // 2]
    b_end = b[:, :, -1:]
    att = jnp.einsum('bcthk,bcshk->bchts', q * jnp.exp(b - b_mid), k * jnp.exp(b_mid - b))
    tri = jnp.tril(jnp.ones((GLA_CHUNK, GLA_CHUNK), dtype=bool))
    o = jnp.einsum('bchts,bcshv->bcthv', jnp.where(tri, att, 0.0), v)
    ds = jnp.einsum('bcshk,bcshv->bchkv', k * jnp.exp(b_end - b), v)
    decay = jnp.exp(b_end[:, :, 0])

    def step(s, inp):
        d, dsc = inp
        return d[..., None] * s + dsc, s

    s_last, s_start = lax.scan(step, s0, (jnp.moveaxis(decay, 1, 0), jnp.moveaxis(ds, 1, 0)))
    o = o + jnp.einsum('bcthk,cbhkv->bcthv', q * jnp.exp(b), s_start)
    return o.reshape(B, n, H, v.shape[-1]), s_last


def gla_final_state(k, v, g):
    bc = jnp.cumsum(g, axis=1)
    return jnp.einsum('bshk,bshv->bhkv', k * jnp.exp(bc[:, -1:] - bc), v)


def gla_bidir(q_l, k_l, v_l, g_l, k_c, v_c, g_c, q_c):
    B, _, H, _ = k_c.shape
    ident = lambda a: a
    rev = lambda a: a[:, ::-1]
    o_l, o_c = 0.0, 0.0
    for d, order in ((0, ident), (1, rev)):
        if q_c is None:
            s_c = gla_final_state(order(k_c), order(v_c), order(g_c[d]))
        else:
            s0 = jnp.zeros((B, H, GLA_DK, GLA_DV), jnp.float32)
            oc, s_c = gla_chunk_scan(order(q_c), order(k_c), order(v_c), order(g_c[d]), s0)
            o_c = o_c + order(oc)
        ol, _ = gla_chunk_scan(order(q_l), order(k_l), order(v_l), order(g_l[d]), s_c)
        o_l = o_l + order(ol)
    return o_l, (o_c if q_c is not None else None)


def mla_q(cq, q_norm_g, w_uq, rope):
    B, n, _ = cq.shape
    q = jnp.einsum('bnr,re->bne', rms_norm(cq, q_norm_g), w_uq).reshape(B, n, MLA_HEADS, MLA_NOPE + MLA_ROPE)
    q_nope, q_rope = q[..., :MLA_NOPE], q[..., MLA_NOPE:]
    if rope is not None:
        q_rope = apply_rope(q_rope, rope[0][:, None, :], rope[1][:, None, :])
    return q_nope, q_rope


def mla_kv(ckv, kr, kv_norm_g, w_ukv, rope):
    B, n, _ = ckv.shape
    kv = jnp.einsum('bnr,re->bne', rms_norm(ckv, kv_norm_g), w_ukv).reshape(B, n, MLA_HEADS, MLA_NOPE + MLA_V)
    if rope is not None:
        kr = apply_rope(kr, rope[0], rope[1])
    return kv[..., :MLA_NOPE], kr, kv[..., MLA_NOPE:]


def mla_attend(q_nope, q_rope, k_nope, k_rope, v):
    s = (jnp.einsum('bqhd,bkhd->bhqk', q_nope, k_nope, preferred_element_type=jnp.float32)
         + jnp.einsum('bqhr,bkr->bhqk', q_rope, k_rope, preferred_element_type=jnp.float32)) * MLA_SCALE
    p = jax.nn.softmax(s, axis=-1).astype(v.dtype)
    return jnp.einsum('bhqk,bkhd->bqhd', p, v)


def mla_latent_blocks(q_nope, q_rope, k_nope, k_rope, v):
    B, n = q_nope.shape[:2]
    nb = n // Q_BLOCK
    blocks = lambda a: jnp.moveaxis(a.reshape(B, nb, Q_BLOCK, *a.shape[2:]), 1, 0)
    o = lax.map(lambda qs: mla_attend(qs[0], qs[1], k_nope, k_rope, v), (blocks(q_nope), blocks(q_rope)))
    return jnp.moveaxis(o, 0, 1).reshape(B, n, MLA_V_W)


def even_mixer(h_lat, h_ctx, need_ctx_out, rope, w_in, gla_w2, gla_b, gla_norm_g,
               q_norm_g, w_uq, kv_norm_g, w_ukv, w_out):
    B, n, _ = h_lat.shape
    L = h_ctx.shape[1]
    proj = lambda h: split_cols(jnp.einsum('bnd,de->bne', h, w_in), EVEN_IN_SIZES)
    gq_l, gk_l, gv_l, glr_l, gg_l, cq_l, ckv_l, kr_l, mg_l = proj(h_lat)
    gq_c, gk_c, gv_c, glr_c, gg_c, cq_c, ckv_c, kr_c, mg_c = proj(h_ctx)

    k_l, v_l, g_l = gla_kvg(gk_l, gv_l, glr_l, gla_w2, gla_b)
    k_c, v_c, g_c = gla_kvg(gk_c, gv_c, glr_c, gla_w2, gla_b)
    o_gl, o_gc = gla_bidir(gla_q(gq_l), k_l, v_l, g_l, k_c, v_c, g_c,
                           gla_q(gq_c) if need_ctx_out else None)
    y_gla = rms_norm(o_gl, gla_norm_g).reshape(B, n, GLA_V_W).astype(h_lat.dtype) * jax.nn.silu(gg_l)

    kn_c, krot_c, vm_c = mla_kv(ckv_c, kr_c, kv_norm_g, w_ukv, None)
    kn_l, krot_l, vm_l = mla_kv(ckv_l, kr_l, kv_norm_g, w_ukv, rope)
    qn_l, qr_l = mla_q(cq_l, q_norm_g, w_uq, rope)
    o_ml = mla_latent_blocks(qn_l, qr_l,
                             jnp.concatenate([kn_c, kn_l], 1),
                             jnp.concatenate([krot_c, krot_l], 1),
                             jnp.concatenate([vm_c, vm_l], 1))
    y_mla = o_ml * jax.nn.silu(mg_l)
    y_lat = jnp.einsum('bne,ed->bnd', jnp.concatenate([y_gla, y_mla], -1), w_out)

    y_ctx = None
    if need_ctx_out:
        yg_c = rms_norm(o_gc, gla_norm_g).reshape(B, L, GLA_V_W).astype(h_ctx.dtype) * jax.nn.silu(gg_c)
        qn_c, qr_c = mla_q(cq_c, q_norm_g, w_uq, None)
        ym_c = mla_attend(qn_c, qr_c, kn_c, krot_c, vm_c).reshape(B, L, MLA_V_W) * jax.nn.silu(mg_c)
        y_ctx = jnp.einsum('bne,ed->bnd', jnp.concatenate([yg_c, ym_c], -1), w_out)
    return y_lat, y_ctx


def odd_mixer(h, w_in, sgu_w, sgu_b, w_out):
    B, n, _ = h.shape
    f, f_gate, u, v, s_gate = split_cols(jnp.einsum('bnd,de->bne', h, w_in), ODD_IN_SIZES)
    fg = f.astype(jnp.float32).reshape(B, n, FNET_GROUPS, FNET_GROUP_CH)
    fr = jnp.fft.fft2(fg, axes=(1, 3), norm='ortho').real.reshape(B, n, FNET_W).astype(h.dtype)
    y_f = fr * jax.nn.silu(f_gate)
    u = jax.nn.gelu(u, approximate=False)
    vg = layer_norm(jax.nn.gelu(v, approximate=False).reshape(B, n // SGU_CHUNK, SGU_CHUNK, SGU_GROUPS, SGU_GROUP_CH))
    sv = jnp.einsum('gts,bcsgd->bctgd', sgu_w, vg) + sgu_b.T[:, :, None]
    y_s = u * sv.reshape(B, n, SGU_W) * jax.nn.silu(s_gate)
    return jnp.einsum('bne,ed->bnd', jnp.concatenate([y_f, y_s], -1), w_out)


def setup_inputs(seed: int = 0) -> dict:
    key = jax.random.key(seed)
    ks = iter(jax.random.split(key, 24))
    nrm = lambda shape, scale: jax.random.normal(next(ks), shape, jnp.float32) * scale
    D = D_MODEL
    return {
        "x": nrm((BATCH, SEQ, D), 1.0),
        "c": nrm((BATCH, D), 1.0),
        "ctx": nrm((BATCH, CTX_LEN, D), 1.0),
        "c_ctx": nrm((D,), 1.0),
        "ada_w": nrm((DEPTH, D, 3 * D), D ** -0.5),
        "ada_b": nrm((DEPTH, 3 * D), 0.02),
        "post_ln_g": 1.0 + nrm((DEPTH, D), 0.02),
        "post_ln_b": nrm((DEPTH, D), 0.02),
        "even_w_in": nrm((N_EVEN, D, sum(EVEN_IN_SIZES)), D ** -0.5),
        "gla_w2": nrm((N_EVEN, 2, GLA_GATE_RANK, GLA_QK_W), GLA_GATE_RANK ** -0.5),
        "gla_b": nrm((N_EVEN, 2, GLA_QK_W), 0.1),
        "gla_norm_g": 1.0 + nrm((N_EVEN, GLA_DV), 0.02),
        "mla_q_norm_g": 1.0 + nrm((N_EVEN, MLA_Q_RANK), 0.02),
        "mla_w_uq": nrm((N_EVEN, MLA_Q_RANK, MLA_HEADS * (MLA_NOPE + MLA_ROPE)), MLA_Q_RANK ** -0.5),
        "mla_kv_norm_g": 1.0 + nrm((N_EVEN, MLA_KV_RANK), 0.02),
        "mla_w_ukv": nrm((N_EVEN, MLA_KV_RANK, MLA_HEADS * (MLA_NOPE + MLA_V)), MLA_KV_RANK ** -0.5),
        "even_w_out": nrm((N_EVEN, EVEN_OUT_IN, D), EVEN_OUT_IN ** -0.5 * DEEPNORM_BETA),
        "odd_w_in": nrm((N_ODD, D, sum(ODD_IN_SIZES)), D ** -0.5),
        "sgu_w": nrm((N_ODD, SGU_GROUPS, SGU_CHUNK, SGU_CHUNK), SGU_CHUNK ** -0.5),
        "sgu_b": 1.0 + nrm((N_ODD, SGU_GROUPS, SGU_CHUNK), 0.1),
        "odd_w_out": nrm((N_ODD, ODD_OUT_IN, D), ODD_OUT_IN ** -0.5 * DEEPNORM_BETA),
    }


def reference(x, c, ctx, c_ctx, ada_w, ada_b, post_ln_g, post_ln_b, even_w_in, gla_w2, gla_b, gla_norm_g,
              mla_q_norm_g, mla_w_uq, mla_kv_norm_g, mla_w_ukv, even_w_out, odd_w_in, sgu_w, sgu_b, odd_w_out):
    rope = axial_rope_angles(x.shape[1])
    for l in range(DEPTH):
        need_ctx_out = any(j % 2 == 0 for j in range(l + 1, DEPTH))
        i = l // 2
        shift, scale, gate = ada_mod(c, ada_w[l], ada_b[l])
        h_lat = modulate(x, shift, scale)
        if l % 2 == 0 or need_ctx_out:
            shift_c, scale_c, gate_c = ada_mod(c_ctx, ada_w[l], ada_b[l])
            h_ctx = modulate(ctx, shift_c, scale_c)
        if l % 2 == 0:
            y_lat, y_ctx = even_mixer(h_lat, h_ctx, need_ctx_out, rope, even_w_in[i], gla_w2[i], gla_b[i],
                                      gla_norm_g[i], mla_q_norm_g[i], mla_w_uq[i], mla_kv_norm_g[i],
                                      mla_w_ukv[i], even_w_out[i])
        else:
            y_lat = odd_mixer(h_lat, odd_w_in[i], sgu_w[i], sgu_b[i], odd_w_out[i])
            y_ctx = odd_mixer(h_ctx, odd_w_in[i], sgu_w[i], sgu_b[i], odd_w_out[i]) if need_ctx_out else None
        x = layer_norm(DEEPNORM_ALPHA * x + gate[:, None, :] * y_lat, post_ln_g[l], post_ln_b[l])
        if need_ctx_out:
            ctx = layer_norm(DEEPNORM_ALPHA * ctx + gate_c[None, :] * y_ctx, post_ln_g[l], post_ln_b[l])
    return x
```

```cpp
#include <hip/hip_runtime.h>
#include <hip/hip_cooperative_groups.h>
#include <cstdio>
#include <cstdint>
namespace cg = cooperative_groups;

typedef unsigned short bf16;
using bf16x8 = __attribute__((ext_vector_type(8))) short;
using f32x4 = __attribute__((ext_vector_type(4))) float;
using u32x4 = __attribute__((ext_vector_type(4))) unsigned;
using u32x2 = __attribute__((ext_vector_type(2))) unsigned;
using f32x16 = __attribute__((ext_vector_type(16))) float;
using s16x4 = __attribute__((ext_vector_type(4))) short;
typedef __bf16 hwbf16x2 __attribute__((ext_vector_type(2)));
#define MFMA32(a, b, c) __builtin_amdgcn_mfma_f32_32x32x16_bf16((a), (b), (c), 0, 0, 0)
#define DI __device__ __forceinline__
#define NT 256
#ifndef PROBE
#define PROBE 0
#endif

constexpr int D = 1024, NB = 2, S = 8192, L = 256, T = S + L;
constexpr int MLAT = NB * S, MCTX = NB * L, MT = MLAT + MCTX;
constexpr int LDP = 2560;
constexpr float ALPHA = 1.6817928305074290f;
constexpr float LN_EPS = 1e-6f;
constexpr int C_GQ = 0, C_GK = 256, C_GV = 512, C_GLR = 1024, C_GG = 1056, C_CQ = 1568, C_CKV = 1824, C_KR = 1952, C_MG = 1984, E_EVEN = 2496;
constexpr int C_F = 0, C_FG = 512, C_U = 1024, C_V = 1536, C_SG = 2048, E_ODD = 2560;
constexpr float QSCALE = 0.10206207261596575f * 1.4426950408889634f;

constexpr size_t al(size_t x) { return (x + 255) & ~(size_t)255; }
constexpr size_t WS_BAR = 0;
constexpr size_t WS_MOD = al(WS_BAR + 16384);
constexpr size_t WS_XC  = al(WS_MOD + 4 * 3 * 3072 * 4);
constexpr size_t WS_WL  = al(WS_XC + (size_t)MCTX * D * 4);
constexpr size_t WS_TAB = al(WS_WL + (size_t)13 * 1024 * 1024);
constexpr size_t WS_HY  = al(WS_TAB + (size_t)2 * 1024 * 1024);
constexpr size_t WS_P   = al(WS_HY + (size_t)MT * D * 2);
constexpr size_t WS_U   = al(WS_P + (size_t)MT * LDP * 2);
constexpr size_t WS_Q   = WS_U;
constexpr size_t WS_QC  = al(WS_Q + (size_t)NB * 8 * S * 96 * 2);
constexpr size_t WS_K   = al(WS_QC + (size_t)NB * 8 * L * 96 * 2);
constexpr size_t WS_VT  = al(WS_K + (size_t)NB * 8 * T * 96 * 2);
constexpr size_t WS_G   = al(WS_VT + (size_t)NB * 8 * 64 * T * 2);
constexpr size_t WS_DEC = al(WS_G + (size_t)4 * 132 * 4 * 8192 * 2);
static_assert(WS_DEC + (size_t)4 * 132 * 4 * 64 * 4 <= WS_G + (size_t)MT * 512 * 6, "DS/DEC");
constexpr size_t WS_OG  = al(WS_G + (size_t)MT * 512 * 2);
constexpr size_t WS_END_EVEN = al(WS_OG + (size_t)MT * 512 * 4);
constexpr size_t WS_ZN  = WS_U;
constexpr size_t WS_VG  = al(WS_ZN + (size_t)MT * 1024 * 2);
constexpr size_t WS_ZT  = WS_U;
constexpr size_t WS_ZTC = al(WS_ZT + (size_t)NB * 512 * 128 * 128 * 2);
constexpr size_t WS_UT  = al(WS_ZTC + (size_t)NB * 512 * 512 * 2);
constexpr size_t WS_VGT = al(WS_UT + (size_t)NB * 64 * 512 * 256 * 2);
constexpr size_t WS_END_ODD = al(WS_VGT + (size_t)528 * 128 * 128 * 2);
constexpr size_t WS_END = WS_END_EVEN > WS_END_ODD ? WS_END_EVEN : WS_END_ODD;
static_assert(WS_END <= (size_t)256 * 1024 * 1024, "workspace");
constexpr size_t WL_IN = 0, WL_OUT = (size_t)2560 * 1024 * 2, WL_UQ = WL_OUT + (size_t)1024 * 1024 * 2, WL_UKV = WL_UQ + (size_t)768 * 256 * 2,
                 WL_SGU = WL_UKV + (size_t)1024 * 128 * 2, WL_END = WL_SGU + (size_t)4 * 128 * 128 * 2;
constexpr size_t WL_W2F = (size_t)8448 * 1024;
static_assert(WL_END <= WL_W2F && WL_W2F + (size_t)8192 * 256 * 2 <= (size_t)13 * 1024 * 1024, "WL");
constexpr size_t TBB_CS128 = (size_t)1280 * 1024, TBB_W1 = TBB_CS128 + 256 * 128 * 2, TBB_W256 = TBB_W1 + 128 * 128 * 2, TBB_END = TBB_W256 + 256 * 512 * 2;
static_assert(TBB_END <= (size_t)2 * 1024 * 1024, "TAB");
constexpr int TB_C128 = 0, TB_S128 = 128, TB_C8K = 256, TB_S8K = 256 + 8192, TB_ROPE = 256 + 16384;

struct Params {
  const float *x, *c, *ctx, *c_ctx, *ada_w, *ada_b, *post_g, *post_b, *even_w_in, *gla_w2, *gla_b, *gla_norm_g,
      *q_norm_g, *w_uq, *kv_norm_g, *w_ukv, *even_w_out, *odd_w_in, *sgu_w, *sgu_b, *odd_w_out;
  float* out; unsigned char* ws;
};

DI int otid() { int t = threadIdx.x; asm volatile("" : "+v"(t)); return t; }
DI float bf2f(bf16 v) { return __uint_as_float(((unsigned)v) << 16); }
DI bf16 f2bf(float f) { unsigned u = __float_as_uint(f); u += 0x7fffu + ((u >> 16) & 1u); return (bf16)(u >> 16); }
DI float silu(float x) { return x * __builtin_amdgcn_rcpf(1.f + __expf(-x)); }
DI float erf_as(float x) {
  const float ax = fabsf(x);
  const float t = __builtin_amdgcn_rcpf(1.f + 0.3275911f * ax);
  const float poly = t * (0.254829592f + t * (-0.284496736f + t * (1.421413741f + t * (-1.453152027f + t * 1.061405429f))));
  const float y = 1.f - poly * __builtin_amdgcn_exp2f(-1.4426950408889634f * ax * ax);
  return copysignf(y, x);
}
DI float gelu(float x) { return 0.5f * x * (1.f + erf_as(x * 0.70710678118654752f)); }
DI float logsigmoid(float z) { return fminf(z, 0.f) - log1pf(__expf(-fabsf(z))); }
DI float logsigmoid_fast(float z) { return -0.6931471805599453f * __builtin_amdgcn_logf(1.f + __builtin_amdgcn_exp2f(-1.4426950408889634f * fmaxf(z, -80.f))); }
template <int CTRL> DI float dpp_add(float v) { return v + __builtin_bit_cast(float, __builtin_amdgcn_update_dpp(0, __builtin_bit_cast(int, v), CTRL, 0xf, 0xf, false)); }
DI float wave_sum(float v) {
  v = dpp_add<0x128>(v); v = dpp_add<0x124>(v); v = dpp_add<0x122>(v); v = dpp_add<0x121>(v);
  v += __shfl_xor(v, 16);
  const unsigned u = __float_as_uint(v);
  auto r = __builtin_amdgcn_permlane32_swap(u, u, false, false);
  return __uint_as_float(r[0]) + __uint_as_float(r[1]);
}
DI int mod_row(int row) { return row < MLAT ? (row >> 13) : 2; }

struct Ctx {
  Params p;
  float* sm;
  DI float* MOD() const { return (float*)(p.ws + WS_MOD); }
  DI float* XC() const { return (float*)(p.ws + WS_XC); }
  DI float* TAB() const { return (float*)(p.ws + WS_TAB); }
  DI bf16* WL() const { return (bf16*)(p.ws + WS_WL); }
  DI bf16* HY() const { return (bf16*)(p.ws + WS_HY); }
  DI bf16* P() const { return (bf16*)(p.ws + WS_P); }
  DI bf16* Q() const { return (bf16*)(p.ws + WS_Q); }
  DI bf16* QC() const { return (bf16*)(p.ws + WS_QC); }
  DI bf16* K() const { return (bf16*)(p.ws + WS_K); }
  DI bf16* VT() const { return (bf16*)(p.ws + WS_VT); }
  DI bf16* G() const { return (bf16*)(p.ws + WS_G); }
  DI float* DEC() const { return (float*)(p.ws + WS_DEC); }
  DI bf16* ZT() const { return (bf16*)(p.ws + WS_ZT); }
  DI bf16* ZTC() const { return (bf16*)(p.ws + WS_ZTC); }
  DI bf16* UT() const { return (bf16*)(p.ws + WS_UT); }
  DI bf16* VGT() const { return (bf16*)(p.ws + WS_VGT); }
  DI float* xrow(int row) const { return row < MLAT ? p.out + (size_t)row * D : XC() + (size_t)(row - MLAT) * D; }
  DI const float* xin(int row) const { return row < MLAT ? p.x + (size_t)row * D : p.ctx + (size_t)(row - MLAT) * D; }
};

DI void phase_prologue(const Ctx& c) {
  const Params& p = c.p;
  const int tid = otid();
  for (int i = tid; i < 3072; i += NT) { const float v = (i < 2048) ? p.c[i] : p.c_ctx[i - 2048]; c.sm[i] = silu(v); }
  __syncthreads();
  for (int item = blockIdx.x; item < 4 * 12 * 16; item += gridDim.x) {
    const int l = item / 192, rem = item % 192, cb = rem >> 4, ks = rem & 15, col = cb * 256 + tid;
    const float* w = p.ada_w + ((size_t)l * D + ks * 64) * 3072 + col;
    float a0 = 0.f, a1 = 0.f, a2 = 0.f;
#pragma unroll 8
    for (int d = 0; d < 64; ++d) { const float wv = w[(size_t)d * 3072]; a0 += c.sm[ks * 64 + d] * wv; a1 += c.sm[1024 + ks * 64 + d] * wv; a2 += c.sm[2048 + ks * 64 + d] * wv; }
    if (ks == 0) { const float bb = p.ada_b[l * 3072 + col]; a0 += bb; a1 += bb; a2 += bb; }
    atomicAdd(c.MOD() + (l * 3 + 0) * 3072 + col, a0); atomicAdd(c.MOD() + (l * 3 + 1) * 3072 + col, a1); atomicAdd(c.MOD() + (l * 3 + 2) * 3072 + col, a2);
  }
  __syncthreads();
  const int gt = blockIdx.x * NT + tid, gs = gridDim.x * NT;
  for (int i = gt; i < 8192 * 16; i += gs) {
    const int t = i >> 4, f = i & 15;
    const float pos = (f < 8) ? (float)(t >> 6) : (float)(t & 63);
    const float inv = powf(10000.f, -(float)(f & 7) / 8.f);
    const float ang = pos * inv;
    c.TAB()[TB_ROPE + i * 2] = cosf(ang); c.TAB()[TB_ROPE + i * 2 + 1] = sinf(ang);
  }
  {
    bf16* cs128 = (bf16*)((unsigned char*)c.TAB() + TBB_CS128);
    for (int i = gt; i < 256 * 128; i += gs) { const int n = i >> 7, cc = i & 127, ri = n >> 7, j = n & 127; float sv, cv; { const float fr_ = (float)((j * cc) & 127) / 128.f; sv = __builtin_amdgcn_sinf(fr_); cv = __builtin_amdgcn_cosf(fr_); } cs128[i] = f2bf(ri ? -sv : cv); }
    bf16* w1 = (bf16*)((unsigned char*)c.TAB() + TBB_W1);
    for (int i = gt; i < 128 * 128; i += gs) {
      const int n = i >> 7, k = i & 127, ro = n >> 6, k1 = n & 63, ri = k >> 6, t1 = k & 63; float sv, cv; { const float fr_ = (float)((k1 * t1) & 63) / 64.f; sv = __builtin_amdgcn_sinf(fr_); cv = __builtin_amdgcn_cosf(fr_); }
      w1[i] = f2bf(ro == ri ? cv : (ro ? -sv : sv));
    }
    bf16* w256 = (bf16*)((unsigned char*)c.TAB() + TBB_W256);
    for (int i = gt; i < 256 * 512; i += gs) { const int k = i >> 9, kk = i & 511, ri = kk >> 8, t = kk & 255; float sv, cv; { const float fr_ = (float)((k * t) & 255) / 256.f; sv = __builtin_amdgcn_sinf(fr_); cv = __builtin_amdgcn_cosf(fr_); } w256[i] = f2bf(ri ? sv : cv); }
    bf16* w2f = c.WL() + WL_W2F / 2;
    for (int i = gt; i < 8192 * 256; i += gs) { const int k = i >> 8, kk = i & 255, ri = kk >> 7, t2 = kk & 127; float sv, cv; { const float fr_ = (float)((k * t2) & 8191) / 8192.f; sv = __builtin_amdgcn_sinf(fr_); cv = __builtin_amdgcn_cosf(fr_); } w2f[i] = f2bf(ri ? sv : cv); }
  }
}

DI void ln_row(const Ctx& c, int row, int l_post, int l_next, int lane) {
  const Params& p = c.p;
    const bool lat = row < MLAT;
    const bool do_post = (l_post >= 0) && (lat || l_post <= 1);
    const bool do_h = (l_next >= 0) && (lat || l_next <= 2);
    if (!do_post && !do_h) return;
    if (l_post >= 0 && !do_post) return;
    const float* src = (l_post < 0) ? c.xin(row) : c.xrow(row);
    float v[16];
#pragma unroll
    for (int i = 0; i < 4; ++i) { const float4 t = *(const float4*)(src + i * 256 + lane * 4); v[i * 4] = t.x; v[i * 4 + 1] = t.y; v[i * 4 + 2] = t.z; v[i * 4 + 3] = t.w; }
    if (do_post) {
      float s = 0.f;
#pragma unroll
      for (int i = 0; i < 16; ++i) s += v[i];
      const float mean = wave_sum(s) * (1.f / D);
      float q = 0.f;
#pragma unroll
      for (int i = 0; i < 16; ++i) { v[i] -= mean; q += v[i] * v[i]; }
      const float rstd = rsqrtf(wave_sum(q) * (1.f / D) + LN_EPS);
      float* dst = c.xrow(row);
#pragma unroll
      for (int i = 0; i < 4; ++i) {
        const int col = i * 256 + lane * 4;
        const float4 g = *(const float4*)(p.post_g + l_post * D + col), b = *(const float4*)(p.post_b + l_post * D + col);
        v[i * 4] = v[i * 4] * rstd * g.x + b.x; v[i * 4 + 1] = v[i * 4 + 1] * rstd * g.y + b.y;
        v[i * 4 + 2] = v[i * 4 + 2] * rstd * g.z + b.z; v[i * 4 + 3] = v[i * 4 + 3] * rstd * g.w + b.w;
        *(float4*)(dst + col) = make_float4(v[i * 4], v[i * 4 + 1], v[i * 4 + 2], v[i * 4 + 3]);
      }
    }
    if (do_h) {
      float s = 0.f;
#pragma unroll
      for (int i = 0; i < 16; ++i) s += v[i];
      const float mean = wave_sum(s) * (1.f / D);
      float q = 0.f;
#pragma unroll
      for (int i = 0; i < 16; ++i) { v[i] -= mean; q += v[i] * v[i]; }
      const float rstd = rsqrtf(wave_sum(q) * (1.f / D) + LN_EPS);
      const float* md = c.MOD() + (l_next * 3 + mod_row(row)) * 3072;
      bf16* dst = c.HY() + (size_t)row * D;
#pragma unroll
      for (int i = 0; i < 4; ++i) {
        const int col = i * 256 + lane * 4;
        const float4 sh = *(const float4*)(md + col), sc = *(const float4*)(md + 1024 + col);
        const float h0 = v[i * 4] * rstd * (1.f + sc.x) + sh.x, h1 = v[i * 4 + 1] * rstd * (1.f + sc.y) + sh.y;
        const float h2 = v[i * 4 + 2] * rstd * (1.f + sc.z) + sh.z, h3 = v[i * 4 + 3] * rstd * (1.f + sc.w) + sh.w;
        uint2 pk; pk.x = (unsigned)f2bf(h0) | ((unsigned)f2bf(h1) << 16); pk.y = (unsigned)f2bf(h2) | ((unsigned)f2bf(h3) << 16);
        *(uint2*)(dst + col) = pk;
      }
    }
}
DI void phase_ln(const Ctx& c, int l_post, int l_next) {
  const int tid = otid(), lane = tid & 63;
  const int wv = (blockIdx.x * NT + tid) >> 6, nw = (gridDim.x * NT) >> 6;
  for (int row = wv; row < MT; row += 2 * nw) { ln_row(c, row, l_post, l_next, lane); if (row + nw < MT) ln_row(c, row + nw, l_post, l_next, lane); }
}

constexpr int GEMM_LDS_BF16 = 2 * 2 * 128 * 72;
template <int TRANS, class AP, class BP, class Epi>
DI void mfma_gemm_tile(const AP& aptr, const BP& bptr, int m0, int n0, int K, const Epi& epi, bf16* lds) {
  const int tid = otid(), lane = tid & 63, wave = __builtin_amdgcn_readfirstlane(tid >> 6);
  const int wm = (wave >> 1) * 64, wn = (wave & 1) * 64;
  const int lr = tid >> 3, lc = ((tid & 7) ^ (lr & 7)) * 8;
  const int l16 = lane & 15, lq = lane >> 4;
  const bf16* ap[4]; const bf16* bp[4];
#pragma unroll
  for (int i = 0; i < 4; ++i) { ap[i] = aptr(m0 + lr + 32 * i) + lc; bp[i] = bptr(n0 + lr + 32 * i) + lc; }
  f32x4 acc[4][4];
#pragma unroll
  for (int i = 0; i < 4; ++i)
#pragma unroll
    for (int j = 0; j < 4; ++j) acc[i][j] = f32x4{0.f, 0.f, 0.f, 0.f};
  const int nk = K >> 6;
#define GEMM_STAGE(buf, ks) do { bf16* As_ = lds + (buf) * (2 * 128 * 64); bf16* Bs_ = As_ + 128 * 64; \
    _Pragma("unroll") for (int i = 0; i < 4; ++i) { \
      __builtin_amdgcn_global_load_lds((const unsigned*)(ap[i] + (ks) * 64), (__attribute__((address_space(3))) unsigned*)(As_ + (i * 256 + wave * 64) * 8), 16, 0, 0); \
      __builtin_amdgcn_global_load_lds((const unsigned*)(bp[i] + (ks) * 64), (__attribute__((address_space(3))) unsigned*)(Bs_ + (i * 256 + wave * 64) * 8), 16, 0, 0); } } while (0)
  GEMM_STAGE(0, 0);
  if (nk > 1) GEMM_STAGE(1, 1);
  const unsigned lbase = (unsigned)(size_t)lds;
  const unsigned sw0 = (unsigned)(((lq ^ (l16 & 7)) * 8) * 2), sw1 = (unsigned)((((4 + lq) ^ (l16 & 7)) * 8) * 2);
  const unsigned a_row = (unsigned)((wm + l16) * 128), b_row = (unsigned)((128 * 64 + (wn + l16) * 64) * 2);
#define LDSR(dst, addr, off) asm volatile("ds_read_b128 %0, %1 offset:%2" : "=&v"(dst) : "v"(addr), "n"(off))
  for (int ks = 0; ks < nk; ++ks) {
    if (ks + 1 < nk) asm volatile("s_waitcnt vmcnt(8)\n\ts_barrier" ::: "memory");
    else asm volatile("s_waitcnt vmcnt(0)\n\ts_barrier" ::: "memory");
    const unsigned sb_ = lbase + (unsigned)((ks & 1) * (2 * 128 * 64) * 2);
    const unsigned a0 = sb_ + a_row + sw0, a1 = sb_ + a_row + sw1, b0 = sb_ + b_row + sw0, b1 = sb_ + b_row + sw1;
    bf16x8 af[2][4], bfr[2][4];
    LDSR(af[0][0], a0, 0); LDSR(af[0][1], a0, 2048); LDSR(af[0][2], a0, 4096); LDSR(af[0][3], a0, 6144);
    LDSR(bfr[0][0], b0, 0); LDSR(bfr[0][1], b0, 2048); LDSR(bfr[0][2], b0, 4096); LDSR(bfr[0][3], b0, 6144);
    LDSR(af[1][0], a1, 0); LDSR(af[1][1], a1, 2048); LDSR(af[1][2], a1, 4096); LDSR(af[1][3], a1, 6144);
    LDSR(bfr[1][0], b1, 0); LDSR(bfr[1][1], b1, 2048); LDSR(bfr[1][2], b1, 4096); LDSR(bfr[1][3], b1, 6144);
    asm volatile("s_waitcnt lgkmcnt(0)" : "+v"(af[0][0]), "+v"(af[0][1]), "+v"(af[0][2]), "+v"(af[0][3]), "+v"(bfr[0][0]), "+v"(bfr[0][1]), "+v"(bfr[0][2]), "+v"(bfr[0][3]),
                 "+v"(af[1][0]), "+v"(af[1][1]), "+v"(af[1][2]), "+v"(af[1][3]), "+v"(bfr[1][0]), "+v"(bfr[1][1]), "+v"(bfr[1][2]), "+v"(bfr[1][3]) : : "memory");
    if (ks + 2 < nk) {
      asm volatile("s_barrier" ::: "memory");
      GEMM_STAGE(ks & 1, ks + 2);
    }
#pragma unroll
    for (int kk = 0; kk < 2; ++kk)
#pragma unroll
      for (int i = 0; i < 4; ++i)
#pragma unroll
        for (int j = 0; j < 4; ++j)
          acc[i][j] = TRANS ? __builtin_amdgcn_mfma_f32_16x16x32_bf16(af[kk][i], bfr[kk][j], acc[i][j], 0, 0, 0)
                            : __builtin_amdgcn_mfma_f32_16x16x32_bf16(bfr[kk][j], af[kk][i], acc[i][j], 0, 0, 0);
  }
#undef LDSR
#undef GEMM_STAGE
#pragma unroll
  for (int i = 0; i < 4; ++i)
#pragma unroll
    for (int j = 0; j < 4; ++j) {
      if (TRANS) epi(m0 + wm + 16 * i + 4 * lq, n0 + wn + 16 * j + l16, acc[i][j]);
      else epi(m0 + wm + 16 * i + l16, n0 + wn + 16 * j + 4 * lq, acc[i][j]);
    }
  asm volatile("s_waitcnt vmcnt(0)" ::: "memory");
  __syncthreads();
}

template <class F>
DI void xcd_items(int total, const F& f) {
  const int G = gridDim.x;
  if ((G & 7) == 0 && (total & 7) == 0) {
    const int x = blockIdx.x & 7, j = blockIdx.x >> 3, per = total >> 3, gl = G >> 3;
    for (int q = j; q < per; q += gl) f(x * per + q);
  } else {
    for (int t = blockIdx.x; t < total; t += G) f(t);
  }
}
struct RowPtr { const bf16* base; int ld; DI const bf16* operator()(int r) const { return base + (size_t)r * ld; } };

template <int TRANS, class AP, class BP, class Epi>
DI void mfma_gemm(const AP& aptr, const BP& bptr, int M, int N, int K, const Epi& epi, bf16* lds) {
  const int tn = N / 128, tiles = (M / 128) * tn;
  for (int t = blockIdx.x; t < tiles; t += gridDim.x) mfma_gemm_tile<TRANS>(aptr, bptr, (t / tn) * 128, (t % tn) * 128, K, epi, lds);
}


constexpr int BG_STAGE = (256 + 128) * 32;
static_assert(3 * BG_STAGE <= GEMM_LDS_BF16, "big GEMM LDS");
template <class AP, class BP, class Epi>
DI void mfma_gemm_big_tile(const AP& aptr, const BP& bptr, int m0, int n0, int K, const Epi& epi, bf16* lds) {
  const int tid = otid(), lane = tid & 63, wave = __builtin_amdgcn_readfirstlane(tid >> 6);
  const int wm = (wave >> 1) * 128, wn = (wave & 1) * 64;
  const int l16 = lane & 15, lq = lane >> 4;
  const int lrow = tid >> 2, lcol = ((tid & 3) ^ ((-(tid >> 4)) & 3)) * 8;
  const bf16* ap[4]; const bf16* bp[2];
#pragma unroll
  for (int i = 0; i < 4; ++i) ap[i] = aptr(m0 + lrow + 64 * i) + lcol;
#pragma unroll
  for (int i = 0; i < 2; ++i) bp[i] = bptr(n0 + lrow + 64 * i) + lcol;
  f32x4 acc[8][4];
#pragma unroll
  for (int i = 0; i < 8; ++i)
#pragma unroll
    for (int j = 0; j < 4; ++j) acc[i][j] = f32x4{0.f, 0.f, 0.f, 0.f};
  const int nk = K >> 5;
#define BG_ISSUE(buf, ks) do { bf16* As_ = lds + (buf) * BG_STAGE; bf16* Bs_ = As_ + 256 * 32; \
    _Pragma("unroll") for (int i = 0; i < 4; ++i) \
      __builtin_amdgcn_global_load_lds((const unsigned*)(ap[i] + (ks) * 32), (__attribute__((address_space(3))) unsigned*)(As_ + (i * 256 + wave * 64) * 8), 16, 0, 0); \
    _Pragma("unroll") for (int i = 0; i < 2; ++i) \
      __builtin_amdgcn_global_load_lds((const unsigned*)(bp[i] + (ks) * 32), (__attribute__((address_space(3))) unsigned*)(Bs_ + (i * 256 + wave * 64) * 8), 16, 0, 0); } while (0)
  BG_ISSUE(0, 0);
  BG_ISSUE(1, 1);
  asm volatile("s_waitcnt vmcnt(6)\n\ts_barrier" ::: "memory");
  const unsigned lbase = (unsigned)(size_t)lds;
  const unsigned a_off = (unsigned)(((wm + l16) * 32 + (lq ^ ((-(l16 >> 2)) & 3)) * 8) * 2);
  const unsigned b_off = (unsigned)((256 * 32 + (wn + l16) * 32 + (lq ^ ((-(l16 >> 2)) & 3)) * 8) * 2);
#define LDSR(dst, addr, off) asm volatile("ds_read_b128 %0, %1 offset:%2" : "=&v"(dst) : "v"(addr), "n"(off))
  int cur = 0, nxt = 2;
  for (int ks = 0; ks < nk; ++ks) {
    if (ks + 2 < nk) BG_ISSUE(nxt, ks + 2);
    const unsigned sa = lbase + (unsigned)(cur * BG_STAGE * 2) + a_off, sb = lbase + (unsigned)(cur * BG_STAGE * 2) + b_off;
    bf16x8 af[8], bfr[4];
    LDSR(bfr[0], sb, 0); LDSR(bfr[1], sb, 1024); LDSR(bfr[2], sb, 2048); LDSR(bfr[3], sb, 3072);
    LDSR(af[0], sa, 0); LDSR(af[1], sa, 1024); LDSR(af[2], sa, 2048); LDSR(af[3], sa, 3072);
    LDSR(af[4], sa, 4096); LDSR(af[5], sa, 5120); LDSR(af[6], sa, 6144); LDSR(af[7], sa, 7168);
    asm volatile("s_waitcnt lgkmcnt(0)" : "+v"(af[0]), "+v"(af[1]), "+v"(af[2]), "+v"(af[3]), "+v"(af[4]), "+v"(af[5]), "+v"(af[6]), "+v"(af[7]),
                 "+v"(bfr[0]), "+v"(bfr[1]), "+v"(bfr[2]), "+v"(bfr[3]) : : "memory");
#pragma unroll
    for (int i = 0; i < 8; ++i)
#pragma unroll
      for (int j = 0; j < 4; ++j) acc[i][j] = __builtin_amdgcn_mfma_f32_16x16x32_bf16(bfr[j], af[i], acc[i][j], 0, 0, 0);
    if (ks + 2 < nk) asm volatile("s_waitcnt vmcnt(6)\n\ts_barrier" ::: "memory");
    else asm volatile("s_waitcnt vmcnt(0)\n\ts_barrier" ::: "memory");
    cur = (cur == 2) ? 0 : cur + 1; nxt = (nxt == 2) ? 0 : nxt + 1;
  }
#undef LDSR
#undef BG_ISSUE
#pragma unroll
  for (int i = 0; i < 8; ++i)
#pragma unroll
    for (int j = 0; j < 4; ++j) epi(m0 + wm + 16 * i + l16, n0 + wn + 16 * j + 4 * lq, acc[i][j]);
  asm volatile("s_waitcnt vmcnt(0)" ::: "memory");
  __syncthreads();
}
template <class AP, class BP, class Epi>
DI void mfma_gemm_big(const AP& aptr, const BP& bptr, int M, int N, int K, const Epi& epi, bf16* lds) {
  const int tn = N / 128, tiles = (M / 256) * tn;
  xcd_items(tiles, [&](int t) { mfma_gemm_big_tile(aptr, bptr, (t / tn) * 256, (t % tn) * 128, K, epi, lds); });
}

DI unsigned pk2(float lo, float hi) { hwbf16x2 v = {(__bf16)lo, (__bf16)hi}; return __builtin_bit_cast(unsigned, v); }
DI u32x2 pk4(f32x4 v) { return u32x2{pk2(v[0], v[1]), pk2(v[2], v[3])}; }
DI f32x4 unpk4(u32x2 u) { return f32x4{__uint_as_float(u[0] << 16), __uint_as_float(u[0] & 0xffff0000u), __uint_as_float(u[1] << 16), __uint_as_float(u[1] & 0xffff0000u)}; }
struct EpiStoreP4 { bf16* P; DI void operator()(int m, int n, f32x4 v) const { uint2 u; u.x = pk2(v[0], v[1]); u.y = pk2(v[2], v[3]); *(uint2*)(P + (size_t)m * LDP + n) = u; } };
struct EpiResid4 {
  const float* xin_lat; const float* xin_ctx; float* x_lat; float* x_ctx; const float* MOD; int l;
  DI void operator()(int m, int n, f32x4 v) const {
    const bool lat = m < MLAT;
    const size_t off = lat ? (size_t)m * D + n : (size_t)(m - MLAT) * D + n;
    float* xp = (lat ? x_lat : x_ctx) + off;
    const float4 xo = (l == 0) ? *(const float4*)((lat ? xin_lat : xin_ctx) + off) : *(const float4*)xp;
    const float4 g = *(const float4*)(MOD + (l * 3 + mod_row(m)) * 3072 + 2048 + n);
    *(float4*)xp = make_float4(ALPHA * xo.x + g.x * v[0], ALPHA * xo.y + g.y * v[1], ALPHA * xo.z + g.z * v[2], ALPHA * xo.w + g.w * v[3]);
  }
};

DI void wconv_t(const float* W, int K, int N, int Npad, bf16* Wt) {
  const size_t gt = (size_t)blockIdx.x * NT + otid(), gs = (size_t)gridDim.x * NT;
  const int kc = K >> 3;
  for (size_t i = gt; i < (size_t)Npad * kc; i += gs) {
    const int n = (int)(i % Npad), k0 = (int)(i / Npad) * 8;
    uint4 u = make_uint4(0, 0, 0, 0);
    if (n < N) {
      const float* w = W + (size_t)k0 * N + n;
      u.x = pk2(w[0], w[(size_t)N]); u.y = pk2(w[(size_t)2 * N], w[(size_t)3 * N]);
      u.z = pk2(w[(size_t)4 * N], w[(size_t)5 * N]); u.w = pk2(w[(size_t)6 * N], w[(size_t)7 * N]);
    }
    *(uint4*)(Wt + (size_t)n * K + k0) = u;
  }
}
DI void phase_wconv_in(const Ctx& c, int l) {
  const Params& p = c.p; const int li = l >> 1;
  if ((l & 1) == 0) wconv_t(p.even_w_in + (size_t)li * D * E_EVEN, D, E_EVEN, 2560, c.WL() + WL_IN / 2);
  else wconv_t(p.odd_w_in + (size_t)li * D * E_ODD, D, E_ODD, 2560, c.WL() + WL_IN / 2);
}
DI void phase_wconv_rest(const Ctx& c, int l) {
  const Params& p = c.p; const int li = l >> 1;
  bf16* WL = c.WL();
  if ((l & 1) == 0) {
    wconv_t(p.even_w_out + (size_t)li * D * D, D, D, D, WL + WL_OUT / 2);
    const size_t gt = (size_t)blockIdx.x * NT + otid(), gs = (size_t)gridDim.x * NT;
    for (size_t i = gt; i < (size_t)768 * 32; i += gs) {
      const int n = (int)(i % 768), k0 = (int)(i / 768) * 8, h = n / 96, j = n - h * 96;
      const int src = (j < 64) ? n : h * 96 + 64 + 16 * ((j - 64) & 1) + ((j - 64) >> 1);
      const float* w = p.w_uq + (size_t)li * 256 * 768 + (size_t)k0 * 768 + src; const float* g = p.q_norm_g + li * 256 + k0;
      u32x4 u;
      u[0] = pk2(w[0] * g[0], w[768] * g[1]); u[1] = pk2(w[2 * 768] * g[2], w[3 * 768] * g[3]);
      u[2] = pk2(w[4 * 768] * g[4], w[5 * 768] * g[5]); u[3] = pk2(w[6 * 768] * g[6], w[7 * 768] * g[7]);
      *(u32x4*)(WL + WL_UQ / 2 + (size_t)n * 256 + k0) = u;
    }
    for (size_t i = gt; i < (size_t)1024 * 16; i += gs) {
      const int n = (int)(i % 1024), k0 = (int)(i / 1024) * 8, part = n >> 9, nn = n & 511, h = nn >> 6, j = nn & 63;
      const int src = h * 128 + part * 64 + j;
      const float* w = p.w_ukv + (size_t)li * 128 * 1024 + (size_t)k0 * 1024 + src; const float* g = p.kv_norm_g + li * 128 + k0;
      u32x4 u;
      u[0] = pk2(w[0] * g[0], w[1024] * g[1]); u[1] = pk2(w[2 * 1024] * g[2], w[3 * 1024] * g[3]);
      u[2] = pk2(w[4 * 1024] * g[4], w[5 * 1024] * g[5]); u[3] = pk2(w[6 * 1024] * g[6], w[7 * 1024] * g[7]);
      *(u32x4*)(WL + WL_UKV / 2 + (size_t)n * 128 + k0) = u;
    }
  } else {
    wconv_t(p.odd_w_out + (size_t)li * D * D, D, D, D, WL + WL_OUT / 2);
    const size_t gt = (size_t)blockIdx.x * NT + otid(), gs = (size_t)gridDim.x * NT;
    for (size_t i = gt; i < (size_t)4 * 128 * 128; i += gs) WL[WL_SGU / 2 + i] = f2bf(p.sgu_w[(size_t)li * 4 * 128 * 128 + i]);
  }
}


template <class Epi>
DI void naive_gemm(const bf16* A, int lda, const float* B, int ldb, int M, int N, int K, const Epi& epi, float* sm) {
  float* As = sm;
  float* Bs = sm + 16 * 64;
  const int tid = otid(), ty = tid >> 4, tx = tid & 15;
  const int tiles_n = N / 64, tiles = (M / 64) * tiles_n;
  for (int tile = blockIdx.x; tile < tiles; tile += gridDim.x) {
    const int m0 = (tile / tiles_n) * 64, n0 = (tile % tiles_n) * 64;
    float acc[4][4];
#pragma unroll
    for (int i = 0; i < 4; ++i)
#pragma unroll
      for (int j = 0; j < 4; ++j) acc[i][j] = 0.f;
    for (int k0 = 0; k0 < K; k0 += 16) {
      {
        const int r = tid >> 2, kk = (tid & 3) * 4;
        const uint2 u = *(const uint2*)(A + (size_t)(m0 + r) * lda + k0 + kk);
        As[(kk + 0) * 64 + r] = bf2f((bf16)(u.x & 0xffff)); As[(kk + 1) * 64 + r] = bf2f((bf16)(u.x >> 16));
        As[(kk + 2) * 64 + r] = bf2f((bf16)(u.y & 0xffff)); As[(kk + 3) * 64 + r] = bf2f((bf16)(u.y >> 16));
        const int kb = tid >> 4, nb = (tid & 15) * 4;
        *(float4*)(Bs + kb * 64 + nb) = *(const float4*)(B + (size_t)(k0 + kb) * ldb + n0 + nb);
      }
      __syncthreads();
#pragma unroll
      for (int k = 0; k < 16; ++k) {
        const float4 a = *(const float4*)(As + k * 64 + ty * 4), b = *(const float4*)(Bs + k * 64 + tx * 4);
        const float av[4] = {a.x, a.y, a.z, a.w}, bv[4] = {b.x, b.y, b.z, b.w};
#pragma unroll
        for (int i = 0; i < 4; ++i)
#pragma unroll
          for (int j = 0; j < 4; ++j) acc[i][j] += av[i] * bv[j];
      }
      __syncthreads();
    }
#pragma unroll
    for (int i = 0; i < 4; ++i)
#pragma unroll
      for (int j = 0; j < 4; ++j) epi(m0 + ty * 4 + i, n0 + tx * 4 + j, acc[i][j]);
  }
}

struct EpiStoreP { bf16* P; DI void operator()(int m, int n, float v) const { P[(size_t)m * LDP + n] = f2bf(v); } };
struct EpiResid {
  const float* xin_lat; const float* xin_ctx; float* x_lat; float* x_ctx; const float* MOD; int l;
  DI void operator()(int m, int n, float v) const {
    const bool lat = m < MLAT;
    const size_t off = lat ? (size_t)m * D + n : (size_t)(m - MLAT) * D + n;
    float* xp = (lat ? x_lat : x_ctx) + off;
    const float xo = (l == 0) ? (lat ? xin_lat : xin_ctx)[off] : *xp;
    const float g = MOD[(l * 3 + mod_row(m)) * 3072 + 2048 + n];
    *xp = ALPHA * xo + g * v;
  }
};

constexpr int AK_LD = 104, AV_LD = 68;
constexpr int ATT_BUF = 64 * AK_LD + 64 * AV_LD;
DI float xhalf_max(float x) {
  const unsigned u = __float_as_uint(x);
  auto r = __builtin_amdgcn_permlane32_swap(u, u, false, false);
  return fmaxf(__uint_as_float(r[0]), __uint_as_float(r[1]));
}
DI float xhalf_sum(float x) {
  const unsigned u = __float_as_uint(x);
  auto r = __builtin_amdgcn_permlane32_swap(u, u, false, false);
  return __uint_as_float(r[0]) + __uint_as_float(r[1]);
}
DI void attn_item(const Ctx& c, int item, bf16* lds) {
  const int tid = otid(), lane = tid & 63, wave = tid >> 6, r = lane & 31, hh = lane >> 5;
  int bh, nk, rowbase; const bf16* Qb;
  if (item < 512) { bh = item >> 5; const int q0 = (item & 31) * 256; nk = T; Qb = c.Q() + ((size_t)bh * S + q0) * 96; rowbase = (bh >> 3) * S + q0; }
  else { bh = item - 512; nk = L; Qb = c.QC() + (size_t)bh * L * 96; rowbase = MLAT + (bh >> 3) * L; }
  const int h = bh & 7;
  const bf16* Kb = c.K() + (size_t)bh * T * 96;
  const bf16* Vb = c.VT() + (size_t)bh * 64 * T;
  bf16x8 qf0[6];
  bf16* Qs = lds + 2 * ATT_BUF + wave * (32 * AK_LD);
  {
    const bf16* qrow = Qb + (size_t)(wave * 64 + r) * 96 + 8 * hh;
#pragma unroll
    for (int s = 0; s < 6; ++s) qf0[s] = *(const bf16x8*)(qrow + 16 * s);
    const bf16* qrow1 = qrow + (size_t)32 * 96;
#pragma unroll
    for (int s = 0; s < 6; ++s) *(bf16x8*)(Qs + r * AK_LD + 16 * s + 8 * hh) = *(const bf16x8*)(qrow1 + 16 * s);
  }
  f32x16 ot[2][2];
#pragma unroll
  for (int i = 0; i < 16; ++i) { ot[0][0][i] = 0.f; ot[0][1][i] = 0.f; ot[1][0][i] = 0.f; ot[1][1][i] = 0.f; }
  float m[2] = {0.f, 0.f}, lsum[2] = {0.f, 0.f};
  u32x4 rk[3], rv[2];
  const int vrow = tid >> 3, vcc = (tid & 7) * 8;
  const unsigned koff = (unsigned)tid * 8u, voff = (unsigned)(vrow * T + vcc);
#pragma unroll
  for (int i = 0; i < 3; ++i) rk[i] = *(const u32x4*)(Kb + (koff + 2048u * i));
#pragma unroll
  for (int i = 0; i < 2; ++i) rv[i] = *(const u32x4*)(Vb + (voff + (unsigned)(32 * T) * i));
  const int ntile = nk >> 6;
  for (int kt = 0; kt < ntile; ++kt) {
    bf16* Ks = lds + (kt & 1) * ATT_BUF;
    bf16* Vs = Ks + 64 * AK_LD;
#pragma unroll
    for (int i = 0; i < 3; ++i) { const int ci = tid + 256 * i; const int row = ci / 12, cc = ci % 12; *(u32x4*)(Ks + row * AK_LD + cc * 8) = rk[i]; }
#pragma unroll
    for (int i = 0; i < 2; ++i) {
      bf16* d = Vs + (vrow + 32 * i) * AV_LD + vcc;
      *(u32x2*)(d) = u32x2{rv[i][0], rv[i][1]}; *(u32x2*)(d + 4) = u32x2{rv[i][2], rv[i][3]};
    }
    __syncthreads();
    if (kt + 1 < ntile) {
      const bf16* kn = Kb + (size_t)(kt + 1) * 64 * 96;
      const bf16* vn = Vb + (kt + 1) * 64;
#pragma unroll
      for (int i = 0; i < 3; ++i) rk[i] = *(const u32x4*)(kn + (koff + 2048u * i));
#pragma unroll
      for (int i = 0; i < 2; ++i) rv[i] = *(const u32x4*)(vn + (voff + (unsigned)(32 * T) * i));
    }
#pragma unroll
    for (int qs = 0; qs < 2; ++qs) {
      __builtin_amdgcn_sched_barrier(0);
      f32x16 st[2];
      {
        f32x16 zz;
#pragma unroll
        for (int i = 0; i < 16; ++i) zz[i] = 0.f;
#pragma unroll
        for (int mt = 0; mt < 2; ++mt)
#pragma unroll
          for (int s = 0; s < 6; ++s) {
            const bf16x8 a = *(const bf16x8*)(Ks + (32 * mt + r) * AK_LD + 16 * s + 8 * hh);
            const bf16x8 qb_ = (qs == 0) ? qf0[s] : *(const bf16x8*)(Qs + r * AK_LD + 16 * s + 8 * hh);
            st[mt] = (s == 0) ? MFMA32(a, qb_, zz) : MFMA32(a, qb_, st[mt]);
          }
      }
      if (__builtin_amdgcn_ballot_w64(m[qs] != 0.f) != 0ull) {
#pragma unroll
        for (int i = 0; i < 16; ++i) { st[0][i] -= m[qs]; st[1][i] -= m[qs]; }
      }
      float mx = st[0][0];
#pragma unroll
      for (int i = 1; i < 16; ++i) mx = fmaxf(mx, st[0][i]);
#pragma unroll
      for (int i = 0; i < 16; ++i) mx = fmaxf(mx, st[1][i]);
      mx = xhalf_max(mx);
      if (__builtin_amdgcn_ballot_w64((kt == 0) ? (fabsf(mx) > 16.f) : (mx > 16.f)) != 0ull) {
        const float d = (kt == 0) ? mx : fmaxf(mx, 0.f);
        const float alpha = __builtin_amdgcn_exp2f(-d);
        m[qs] += d; lsum[qs] *= alpha;
#pragma unroll
        for (int i = 0; i < 16; ++i) { ot[qs][0][i] *= alpha; ot[qs][1][i] *= alpha; st[0][i] -= d; st[1][i] -= d; }
      }
      float ps = 0.f;
#pragma unroll
      for (int sp = 0; sp < 4; ++sp) {
        const int mt = sp >> 1, s2 = sp & 1;
        float e[8];
#pragma unroll
        for (int j = 0; j < 8; ++j) { e[j] = __builtin_amdgcn_exp2f(st[mt][8 * s2 + j]); ps += e[j]; }
        u32x4 pk;
        pk[0] = pk2(e[0], e[1]); pk[1] = pk2(e[2], e[3]); pk[2] = pk2(e[4], e[5]); pk[3] = pk2(e[6], e[7]);
        const bf16x8 pf = __builtin_bit_cast(bf16x8, pk);
#pragma unroll
        for (int vt = 0; vt < 2; ++vt) {
          const bf16* vp = Vs + (32 * vt + r) * AV_LD + 32 * mt + 16 * s2 + 4 * hh;
          const s16x4 lo = *(const s16x4*)(vp), hi = *(const s16x4*)(vp + 8);
          const bf16x8 a = __builtin_shufflevector(lo, hi, 0, 1, 2, 3, 4, 5, 6, 7);
          ot[qs][vt] = MFMA32(a, pf, ot[qs][vt]);
        }
      }
      lsum[qs] += ps;
    }
  }
  __syncthreads();
#pragma unroll
  for (int qs = 0; qs < 2; ++qs) {
    const float inv = 1.f / xhalf_sum(lsum[qs]);
    const int row = rowbase + wave * 64 + qs * 32 + r;
    const bf16* mg = c.P() + (size_t)row * LDP + C_MG + h * 64;
    bf16* dst = c.HY() + (size_t)row * D + 512 + h * 64;
#pragma unroll
    for (int vt = 0; vt < 2; ++vt)
#pragma unroll
      for (int g = 0; g < 4; ++g) {
        const int vd = 32 * vt + 8 * g + 4 * hh;
        const f32x4 g4 = unpk4(*(const u32x2*)(mg + vd));
        f32x4 o = {ot[qs][vt][4 * g] * inv * silu(g4[0]), ot[qs][vt][4 * g + 1] * inv * silu(g4[1]), ot[qs][vt][4 * g + 2] * inv * silu(g4[2]), ot[qs][vt][4 * g + 3] * inv * silu(g4[3])};
        *(u32x2*)(dst + vd) = pk4(o);
      }
  }
}

DI void row_rstd(const bf16* base, int ncols, float* rs) {
  const int tid = otid(), row = tid >> 1, half = tid & 1;
  const bf16* pp = base + (size_t)row * LDP + half * (ncols >> 1);
  float ss = 0.f;
  for (int i = 0; i < (ncols >> 4); ++i) {
    const u32x4 u = *(const u32x4*)(pp + i * 8);
#pragma unroll
    for (int j = 0; j < 4; ++j) { const float a = __uint_as_float(u[j] << 16), b = __uint_as_float(u[j] & 0xffff0000u); ss += a * a + b * b; }
  }
  ss += __shfl_xor(ss, 1);
  if (!half) rs[row] = rsqrtf(ss / (float)ncols + LN_EPS);
  __syncthreads();
}
struct RowPos { int b, pos; bool lat; };
DI RowPos row_pos(int m) { RowPos r; r.lat = m < MLAT; if (r.lat) { r.b = m >> 13; r.pos = m & 8191; } else { const int mc = m - MLAT; r.b = mc >> 8; r.pos = mc & 255; } return r; }

struct EpiQ { bf16* Q; bf16* QC; const float* rope; const float* rs; int m0;
  DI void operator()(int m, int n, f32x4 v) const {
    const float sc = rs[m - m0] * QSCALE;
    const int h = n / 96, j = n - h * 96;
    const RowPos rp = row_pos(m);
    bf16* dst = rp.lat ? Q + ((size_t)(rp.b * 8 + h) * S + rp.pos) * 96 + j : QC + ((size_t)(rp.b * 8 + h) * L + rp.pos) * 96 + j;
    f32x4 o;
    if (j < 64 || !rp.lat) { o = v * sc; }
    else {
      const float4 cs = *(const float4*)(rope + (rp.pos * 16 + ((j - 64) >> 1)) * 2);
      o[0] = (v[0] * cs.x - v[1] * cs.y) * sc; o[1] = (v[0] * cs.y + v[1] * cs.x) * sc;
      o[2] = (v[2] * cs.z - v[3] * cs.w) * sc; o[3] = (v[2] * cs.w + v[3] * cs.z) * sc;
    }
    *(u32x2*)dst = pk4(o);
  } };
struct EpiK { bf16* K; const float* rs; int m0;
  DI void operator()(int m, int n, f32x4 v) const {
    const RowPos rp = row_pos(m); const int pos = rp.lat ? L + rp.pos : rp.pos, h = n >> 6, j = n & 63;
    *(u32x2*)(K + ((size_t)(rp.b * 8 + h) * T + pos) * 96 + j) = pk4(v * rs[m - m0]);
  } };
struct EpiV { bf16* VT; const float* rs; int m0;
  DI void operator()(int m, int n, f32x4 v) const {
    const RowPos rp = row_pos(m); const int pos = rp.lat ? L + rp.pos : rp.pos, h = n >> 6, vd = n & 63;
    const float4 r4 = *(const float4*)(rs + (m - m0));
    f32x4 o = {v[0] * r4.x, v[1] * r4.y, v[2] * r4.z, v[3] * r4.w};
    *(u32x2*)(VT + ((size_t)(rp.b * 8 + h) * 64 + vd) * T + pos) = pk4(o);
  } };

constexpr int GL = 72;
DI int gla_row0(int b, int cm) { return cm < 128 ? b * S + cm * 64 : MLAT + b * L + (cm - 128) * 64; }
DI void gla_gates(const Ctx& c, int li, const float* LR, int h, int dir, float (&bv)[16], float& bmid, float& bend, float* sred) {
  const Params& p = c.p;
  const int tid = otid(), k = tid & 63, tq = tid >> 6;
  float w2r[16];
#pragma unroll
  for (int r = 0; r < 16; ++r) w2r[r] = p.gla_w2[((size_t)(li * 2 + dir) * 16 + r) * 256 + h * 64 + k];
  const float bias = p.gla_b[(li * 2 + dir) * 256 + h * 64 + k];
#pragma unroll
  for (int i = 0; i < 16; ++i) {
    const float* lr = LR + (16 * tq + i) * 32 + dir * 16;
    float z = bias;
#pragma unroll
    for (int j = 0; j < 4; ++j) {
      const f32x4 f = *(const f32x4*)(lr + 4 * j);
      z += f[0] * w2r[4 * j] + f[1] * w2r[4 * j + 1] + f[2] * w2r[4 * j + 2] + f[3] * w2r[4 * j + 3];
    }
    bv[i] = logsigmoid_fast(z) * (1.f / 16.f);
  }
  if (dir == 0) {
#pragma unroll
    for (int i = 1; i < 16; ++i) bv[i] += bv[i - 1];
    sred[tq * 64 + k] = bv[15];
  } else {
#pragma unroll
    for (int i = 14; i >= 0; --i) bv[i] += bv[i + 1];
    sred[tq * 64 + k] = bv[0];
  }
  __syncthreads();
  const float s0 = sred[k], s1 = sred[64 + k], s2 = sred[128 + k], s3 = sred[192 + k];
  bend = s0 + s1 + s2 + s3;
  float off;
  if (dir == 0) { off = (tq > 0 ? s0 : 0.f) + (tq > 1 ? s1 : 0.f) + (tq > 2 ? s2 : 0.f); bmid = s0 + s1; }
  else { off = (tq < 3 ? s3 : 0.f) + (tq < 2 ? s2 : 0.f) + (tq < 1 ? s1 : 0.f); bmid = s2 + s3; }
#pragma unroll
  for (int i = 0; i < 16; ++i) bv[i] += off;
  __syncthreads();
}
constexpr int GVR = 136;
DI void gla_stage64(const bf16* src, bf16* dst) {
  const int tid = otid();
#pragma unroll
  for (int i = 0; i < 2; ++i) { const int ci = tid + 256 * i, t = ci >> 3, cc = (ci & 7) * 8; *(u32x4*)(dst + t * GL + cc) = *(const u32x4*)(src + (size_t)t * LDP + cc); }
}
DI void gla_stage_v_lr(const Ctx& c, int row0, int h, bf16* Vraw, float* LR) {
  const int tid = otid();
  const bf16* src = c.P() + (size_t)row0 * LDP + C_GV + h * 128;
#pragma unroll
  for (int i = 0; i < 4; ++i) { const int ci = tid + 256 * i, t = ci >> 4, cc = (ci & 15) * 8; *(u32x4*)(Vraw + t * GVR + cc) = *(const u32x4*)(src + (size_t)t * LDP + cc); }
  { const int t = tid >> 2, cc = (tid & 3) * 8; const u32x4 u = *(const u32x4*)(c.P() + (size_t)(row0 + t) * LDP + C_GLR + cc);
    float* d = LR + t * 32 + cc;
    *(f32x4*)d = f32x4{__uint_as_float(u[0] << 16), __uint_as_float(u[0] & 0xffff0000u), __uint_as_float(u[1] << 16), __uint_as_float(u[1] & 0xffff0000u)};
    *(f32x4*)(d + 4) = f32x4{__uint_as_float(u[2] << 16), __uint_as_float(u[2] & 0xffff0000u), __uint_as_float(u[3] << 16), __uint_as_float(u[3] & 0xffff0000u)}; }
}
DI void gla_transpose_v(const bf16* Vraw, bf16* VTs) {
  const int tid = otid(), v = tid & 127, half = tid >> 7;
#pragma unroll
  for (int i = 0; i < 4; ++i) {
    u32x4 w;
#pragma unroll
    for (int j = 0; j < 4; ++j) w[j] = (unsigned)Vraw[(32 * half + 8 * i + 2 * j) * GVR + v] | ((unsigned)Vraw[(32 * half + 8 * i + 2 * j + 1) * GVR + v] << 16);
    *(u32x4*)(VTs + v * GL + 32 * half + 8 * i) = w;
  }
}
DI bf16x8 ldfrag(const bf16* tile, int row, int kk, int lq) { return *(const bf16x8*)(tile + row * GL + kk * 32 + lq * 8); }
#define MFMA16(a, b, c) __builtin_amdgcn_mfma_f32_16x16x32_bf16((a), (b), (c), 0, 0, 0)

DI void gla_g1_item(const Ctx& c, int l, int item, bf16* lds) {
  const int li = l >> 1;
  const int tid = otid(), lane = tid & 63, wave = tid >> 6, l16 = lane & 15, lq = lane >> 4, k = tid & 63, tq = tid >> 6;
  const int cm = item % 132, bh = item / 132, h = bh & 3, b = bh >> 2;
  const int row0 = gla_row0(b, cm);
  bf16* VTs = lds; bf16* KBT = lds + 9216; float* sred = (float*)(lds + 13824); float* LR = (float*)(lds + 14336); bf16* Kraw = lds + 18432; bf16* Vraw = lds + 23040;
  gla_stage64(c.P() + (size_t)row0 * LDP + C_GK + h * 64, Kraw);
  gla_stage_v_lr(c, row0, h, Vraw, LR);
  __syncthreads();
  float kreg[16];
#pragma unroll
  for (int i = 0; i < 16; ++i) kreg[i] = bf2f(Kraw[(16 * tq + i) * GL + k]);
  gla_transpose_v(Vraw, VTs);
  for (int dir = 0; dir < 2; ++dir) {
    float bv[16], bmid, bend;
    gla_gates(c, li, LR, h, dir, bv, bmid, bend, sred);
    u32x4 w0, w1;
    {
      float kv[16];
#pragma unroll
      for (int i = 0; i < 16; ++i) kv[i] = kreg[i] * __expf(bend - bv[i]);
#pragma unroll
      for (int j = 0; j < 4; ++j) { w0[j] = pk2(kv[2 * j], kv[2 * j + 1]); w1[j] = pk2(kv[8 + 2 * j], kv[8 + 2 * j + 1]); }
    }
    *(u32x4*)(KBT + k * GL + 16 * tq) = w0; *(u32x4*)(KBT + k * GL + 16 * tq + 8) = w1;
    const size_t sidx = ((size_t)((b * 2 + dir) * 132 + cm) * 4 + h);
    if (tq == 0) c.DEC()[sidx * 64 + k] = __expf(bend);
    __syncthreads();
    f32x4 acc[2][4];
#pragma unroll
    for (int i = 0; i < 2; ++i)
#pragma unroll
      for (int j = 0; j < 4; ++j) acc[i][j] = f32x4{0.f, 0.f, 0.f, 0.f};
#pragma unroll
    for (int kk = 0; kk < 2; ++kk) {
      bf16x8 af[2], bfr[4];
#pragma unroll
      for (int i = 0; i < 2; ++i) af[i] = ldfrag(VTs, 32 * wave + 16 * i + l16, kk, lq);
#pragma unroll
      for (int j = 0; j < 4; ++j) bfr[j] = ldfrag(KBT, 16 * j + l16, kk, lq);
#pragma unroll
      for (int i = 0; i < 2; ++i)
#pragma unroll
        for (int j = 0; j < 4; ++j) acc[i][j] = MFMA16(bfr[j], af[i], acc[i][j]);
    }
    bf16* dsp = c.G() + sidx * 8192;
#pragma unroll
    for (int i = 0; i < 2; ++i)
#pragma unroll
      for (int j = 0; j < 4; ++j) *(u32x2*)(dsp + (32 * wave + 16 * i + l16) * 64 + 16 * j + 4 * lq) = pk4(acc[i][j]);
    __syncthreads();
  }
}

DI void gla_g2(const Ctx& c) {
  const int gt = blockIdx.x * NT + otid(), gs = gridDim.x * NT;
  for (int i = gt; i < 16 * 8192; i += gs) {
    const int e = i & 8191, kk = e & 63, q = i >> 13, h = q & 3, bd = q >> 2, dir = bd & 1;
    float st = 0.f;
    for (int c0 = 0; c0 < 132; c0 += 12) {
      float dsv[12], dec[12]; bf16* pd[12];
#pragma unroll
      for (int j = 0; j < 12; ++j) {
        const int ci = c0 + j;
        const int cm = dir ? (131 - ci) : (ci < 4 ? 128 + ci : ci - 4);
        const size_t sidx = (size_t)(bd * 132 + cm) * 4 + h;
        pd[j] = c.G() + sidx * 8192 + e;
        dsv[j] = bf2f(*pd[j]); dec[j] = c.DEC()[sidx * 64 + kk];
      }
#pragma unroll
      for (int j = 0; j < 12; ++j) { *pd[j] = f2bf(st); st = dec[j] * st + dsv[j]; }
    }
  }
}

DI void gla_g3_item(const Ctx& c, int l, int item, bf16* lds) {
  const Params& p = c.p; const int li = l >> 1;
  const int tid = otid(), lane = tid & 63, wave = tid >> 6, l16 = lane & 15, lq = lane >> 4, k = tid & 63, tq = tid >> 6;
  const int ncm = (l == 0) ? 132 : 128;
  const int cm = item % ncm, bh = item / ncm, h = bh & 3, b = bh >> 2;
  const int row0 = gla_row0(b, cm);
  bf16* X1 = lds; bf16* X2 = lds + 64 * GL; bf16* VTs = lds + 128 * GL; bf16* STs = lds + 256 * GL; float* sred = (float*)(lds + 384 * GL);
  float* LR = (float*)(lds + 384 * GL + 512);
  gla_stage64(c.P() + (size_t)row0 * LDP + C_GQ + h * 64, X1);
  gla_stage64(c.P() + (size_t)row0 * LDP + C_GK + h * 64, X2);
  gla_stage_v_lr(c, row0, h, STs, LR);
  __syncthreads();
  float qreg[16], kreg[16];
#pragma unroll
  for (int i = 0; i < 16; ++i) { qreg[i] = bf2f(X1[(16 * tq + i) * GL + k]) * 0.125f; kreg[i] = bf2f(X2[(16 * tq + i) * GL + k]); }
  gla_transpose_v(STs, VTs);
  __syncthreads();
  f32x4 o[8];
#pragma unroll
  for (int j = 0; j < 8; ++j) o[j] = f32x4{0.f, 0.f, 0.f, 0.f};
  for (int dir = 0; dir < 2; ++dir) {
    u32x4 stg[4];
    {
      const bf16* sp = c.G() + ((size_t)((b * 2 + dir) * 132 + cm) * 4 + h) * 8192;
#pragma unroll
      for (int i = 0; i < 4; ++i) { const int ci = tid + 256 * i; stg[i] = *(const u32x4*)(sp + (ci >> 3) * 64 + (ci & 7) * 8); }
    }
    float bv[16], bmid, bend;
    gla_gates(c, li, LR, h, dir, bv, bmid, bend, sred);
    float qb[16];
#pragma unroll
    for (int i = 0; i < 16; ++i) {
      X1[(16 * tq + i) * GL + k] = f2bf(qreg[i] * __expf(bv[i] - bmid));
      X2[(16 * tq + i) * GL + k] = f2bf(kreg[i] * __expf(bmid - bv[i]));
      qb[i] = qreg[i] * __expf(bv[i]);
    }
    __syncthreads();
    f32x4 att[4];
#pragma unroll
    for (int j = 0; j < 4; ++j) att[j] = f32x4{0.f, 0.f, 0.f, 0.f};
#pragma unroll
    for (int kk = 0; kk < 2; ++kk) {
      const bf16x8 af = ldfrag(X1, 16 * wave + l16, kk, lq);
#pragma unroll
      for (int j = 0; j < 4; ++j) att[j] = MFMA16(ldfrag(X2, 16 * j + l16, kk, lq), af, att[j]);
    }
    __syncthreads();
    {
      const int t = 16 * wave + l16;
#pragma unroll
      for (int j = 0; j < 4; ++j) {
        f32x4 a = att[j];
#pragma unroll
        for (int r = 0; r < 4; ++r) { const int s_ = 16 * j + 4 * lq + r; if (dir == 0 ? (s_ > t) : (s_ < t)) a[r] = 0.f; }
        *(u32x2*)(X1 + t * GL + 16 * j + 4 * lq) = pk4(a);
      }
#pragma unroll
      for (int i = 0; i < 16; ++i) X2[(16 * tq + i) * GL + k] = f2bf(qb[i]);
#pragma unroll
      for (int i = 0; i < 4; ++i) { const int ci = tid + 256 * i; *(u32x4*)(STs + (ci >> 3) * GL + (ci & 7) * 8) = stg[i]; }
    }
    __syncthreads();
#pragma unroll
    for (int kk = 0; kk < 2; ++kk) {
      const bf16x8 a1 = ldfrag(X1, 16 * wave + l16, kk, lq), a2 = ldfrag(X2, 16 * wave + l16, kk, lq);
#pragma unroll
      for (int j = 0; j < 8; ++j) {
        o[j] = MFMA16(ldfrag(VTs, 16 * j + l16, kk, lq), a1, o[j]);
        o[j] = MFMA16(ldfrag(STs, 16 * j + l16, kk, lq), a2, o[j]);
      }
    }
    __syncthreads();
  }
  float ss = 0.f;
#pragma unroll
  for (int j = 0; j < 8; ++j)
#pragma unroll
    for (int r = 0; r < 4; ++r) ss += o[j][r] * o[j][r];
  ss += __shfl_xor(ss, 16); ss += __shfl_xor(ss, 32);
  const float rstd = rsqrtf(ss * (1.f / 128.f) + LN_EPS);
  const int row = row0 + 16 * wave + l16;
  const bf16* gg = c.P() + (size_t)row * LDP + C_GG + h * 128;
  bf16* dst = c.HY() + (size_t)row * D + h * 128;
#pragma unroll
  for (int j = 0; j < 8; ++j) {
    const int v = 16 * j + 4 * lq;
    const float4 gn = *(const float4*)(p.gla_norm_g + li * 128 + v);
    const f32x4 g4 = unpk4(*(const u32x2*)(gg + v));
    f32x4 y = {o[j][0] * rstd * gn.x * silu(g4[0]), o[j][1] * rstd * gn.y * silu(g4[1]), o[j][2] * rstd * gn.z * silu(g4[2]), o[j][3] * rstd * gn.w * silu(g4[3])};
    *(u32x2*)(dst + v) = pk4(y);
  }
}

DI void phase_even_b(const Ctx& c, int l, bf16* lds) {
  float* rs = (float*)(lds + GEMM_LDS_BF16);
  const int qrows = (l == 0) ? MT : MLAT;
  const int n_q = (qrows / 128) * 6, n_k = 132 * 4, n_v = 132 * 4, n_g1 = 8 * 132;
  const int total = n_q + n_k + n_v + n_g1;
  for (int it0 = blockIdx.x; it0 < total; it0 += gridDim.x) {
    const int it = (it0 < n_g1) ? (n_q + n_k + n_v + it0) : (it0 - n_g1);
    if (it < n_q) {
      const int m0 = (it / 6) * 128, n0 = (it % 6) * 128;
      row_rstd(c.P() + (size_t)m0 * LDP + C_CQ, 256, rs);
      mfma_gemm_tile<0>(RowPtr{c.P() + C_CQ, LDP}, RowPtr{c.WL() + WL_UQ / 2, 256}, m0, n0, 256, EpiQ{c.Q(), c.QC(), c.TAB() + TB_ROPE, rs, m0}, lds);
    } else if (it < n_q + n_k) {
      const int q = it - n_q, m0 = (q >> 2) * 128, n0 = (q & 3) * 128;
      row_rstd(c.P() + (size_t)m0 * LDP + C_CKV, 128, rs);
      mfma_gemm_tile<0>(RowPtr{c.P() + C_CKV, LDP}, RowPtr{c.WL() + WL_UKV / 2, 128}, m0, n0, 128, EpiK{c.K(), rs, m0}, lds);
    } else if (it < n_q + n_k + n_v) {
      const int q = it - n_q - n_k, m0 = (q >> 2) * 128, n0 = (q & 3) * 128;
      row_rstd(c.P() + (size_t)m0 * LDP + C_CKV, 128, rs);
      mfma_gemm_tile<1>(RowPtr{c.P() + C_CKV, LDP}, RowPtr{c.WL() + WL_UKV / 2 + (size_t)512 * 128, 128}, m0, n0, 128, EpiV{c.VT(), rs, m0}, lds);
    } else gla_g1_item(c, l, it - n_q - n_k - n_v, lds);
  }
  const size_t gt = (size_t)blockIdx.x * NT + otid(), gs = (size_t)gridDim.x * NT;
  for (size_t i = gt; i < (size_t)MT * 16; i += gs) {
    const int row = (int)(i >> 4), f = (int)(i & 15);
    const bf16* kr = c.P() + (size_t)row * LDP + C_KR;
    const float x1 = bf2f(kr[f]), x2 = bf2f(kr[16 + f]);
    const RowPos rp = row_pos(row); const int pos = rp.lat ? L + rp.pos : rp.pos;
    float cs = 1.f, sn = 0.f;
    if (rp.lat) { cs = c.TAB()[TB_ROPE + (rp.pos * 16 + f) * 2]; sn = c.TAB()[TB_ROPE + (rp.pos * 16 + f) * 2 + 1]; }
    const unsigned o = pk2(x1 * cs - x2 * sn, x1 * sn + x2 * cs);
    for (int h = 0; h < 8; ++h) *(unsigned*)(c.K() + ((size_t)(rp.b * 8 + h) * T + pos) * 96 + 64 + 2 * f) = o;
  }
}
DI void phase_even_c(const Ctx& c, int l, bf16* lds) {
  gla_g2(c);
  xcd_items(512, [&](int it) { attn_item(c, it, lds); });
}
DI void phase_even_d(const Ctx& c, int l, bf16* lds) {
  const int n_ctx = (l == 0 ? 16 : 0), n_g3 = 8 * ((l == 0) ? 132 : 128);
  for (int it = blockIdx.x; it < n_ctx + n_g3; it += gridDim.x) {
    if (it < n_ctx) attn_item(c, 512 + it, lds);
    else gla_g3_item(c, l, it - n_ctx, lds);
  }
}


struct APChanLat { const bf16* P; int g; DI const bf16* operator()(int m) const { const int b = m >> 13, t2 = (m >> 6) & 127, t1 = m & 63; return P + (size_t)((b << 13) + 128 * t1 + t2) * LDP + C_F + g * 128; } };
struct EpiChanLat { bf16* ZT; int g; DI void operator()(int m, int n, f32x4 v) const {
  const int b = m >> 13, t2 = (m >> 6) & 127, t1 = m & 63, ri = n >> 7, j = n & 127;
  *(u32x2*)(ZT + ((size_t)((b * 512 + g * 128 + j) * 128 + t2)) * 128 + ri * 64 + t1) = pk4(v); } };
struct EpiChanCtx { bf16* ZTC; int g; DI void operator()(int m, int n, f32x4 v) const {
  const int b = m >> 8, t = m & 255, ri = n >> 7, j = n & 127;
  *(u32x2*)(ZTC + (size_t)(b * 512 + g * 128 + j) * 512 + ri * 256 + t) = pk4(v); } };

DI void vgt_tile(const Ctx& c, int ti, bf16* lds) {
  const int tid = otid(), lane = tid & 63, wave = tid >> 6;
  const int row0 = (ti >> 2) * 128, g = ti & 3;
  constexpr int LDT = 136;
  for (int rr = 0; rr < 32; ++rr) {
    const int t = wave * 32 + rr;
    const unsigned u = *(const unsigned*)(c.P() + (size_t)(row0 + t) * LDP + C_V + g * 128 + 2 * lane);
    const float a = gelu(__uint_as_float(u << 16)), b = gelu(__uint_as_float(u & 0xffff0000u));
    const float mean = wave_sum(a + b) * (1.f / 128.f);
    const float da = a - mean, db = b - mean;
    const float rstd = rsqrtf(wave_sum(da * da + db * db) * (1.f / 128.f) + LN_EPS);
    lds[(2 * lane) * LDT + t] = f2bf(da * rstd);
    lds[(2 * lane + 1) * LDT + t] = f2bf(db * rstd);
  }
  __syncthreads();
  {
    const int d = tid >> 1, half = tid & 1;
    bf16* dst = c.VGT() + ((size_t)ti * 128 + d) * 128 + half * 64;
    const bf16* src = lds + d * LDT + half * 64;
#pragma unroll
    for (int i = 0; i < 8; ++i) *(u32x4*)(dst + i * 8) = *(const u32x4*)(src + i * 8);
  }
  __syncthreads();
}

DI void phase_odd_a(const Ctx& c, int l, bf16* lds) {
  const int ntile_sgu = (l == 1) ? 528 : 512;
  const int n_lat = 4 * 128 * 2, n_ctx = (l == 1) ? 4 * 4 * 2 : 0;
  const bf16* cs128 = (const bf16*)((const unsigned char*)c.TAB() + TBB_CS128);
  const int total = ntile_sgu + n_lat + n_ctx;
  for (int it = blockIdx.x; it < total; it += gridDim.x) {
    if (it < ntile_sgu) vgt_tile(c, it, lds);
    else if (it < ntile_sgu + n_lat) {
      const int q = it - ntile_sgu, g = q >> 8, mt = (q >> 1) & 127, nt = q & 1;
      mfma_gemm_tile<1>(APChanLat{c.P(), g}, RowPtr{cs128, 128}, mt * 128, nt * 128, 128, EpiChanLat{c.ZT(), g}, lds);
    } else {
      const int q = it - ntile_sgu - n_lat, g = q >> 3, mt = (q >> 1) & 3, nt = q & 1;
      mfma_gemm_tile<1>(RowPtr{c.P() + (size_t)MLAT * LDP + C_F + g * 128, LDP}, RowPtr{cs128, 128}, mt * 128, nt * 128, 128, EpiChanCtx{c.ZTC(), g}, lds);
    }
  }
}

struct EpiStage1 { bf16* UT; DI void operator()(int m, int n, f32x4 v) const {
  const int b = m >> 16, col = (m >> 7) & 511, t2 = m & 127, ro = n >> 6, k1 = n & 63;
  *(u32x2*)(UT + ((size_t)((b * 64 + k1) * 512 + col)) * 256 + ro * 128 + t2) = pk4(v); } };
struct EpiSgu { const bf16* P; bf16* HY; const float* bias; int row0, g; DI void operator()(int m, int n, f32x4 v) const {
  const int row = row0 + m; const float bs = bias[m];
  const bf16* pr = P + (size_t)row * LDP + g * 128 + n;
  const f32x4 u = unpk4(*(const u32x2*)(pr + C_U)), sg = unpk4(*(const u32x2*)(pr + C_SG));
  f32x4 o;
#pragma unroll
  for (int i = 0; i < 4; ++i) o[i] = gelu(u[i]) * (v[i] + bs) * silu(sg[i]);
  *(u32x2*)(HY + (size_t)row * D + 512 + g * 128 + n) = pk4(o); } };
struct EpiCtxDft { const bf16* P; bf16* HY; DI void operator()(int m, int n, f32x4 v) const {
  const int b = m >> 9, col = m & 511, row = MLAT + b * 256 + n;
  const f32x4 fg = unpk4(*(const u32x2*)(P + (size_t)row * LDP + C_FG + col));
  f32x4 o;
#pragma unroll
  for (int i = 0; i < 4; ++i) o[i] = v[i] * 5.5242717280199e-3f * silu(fg[i]);
  *(u32x2*)(HY + (size_t)row * D + col) = pk4(o); } };

DI void phase_odd_b(const Ctx& c, int l, bf16* lds) {
  const Params& p = c.p; const int li = l >> 1;
  const int n_s1 = 1024, n_sgu = (l == 1) ? 528 : 512, n_ctx = (l == 1) ? 16 : 0;
  const bf16* w1 = (const bf16*)((const unsigned char*)c.TAB() + TBB_W1);
  const bf16* w256 = (const bf16*)((const unsigned char*)c.TAB() + TBB_W256);
  const int total = n_s1 + n_sgu + n_ctx;
  for (int it0 = blockIdx.x; it0 < total; it0 += gridDim.x) {
    const int it = (it0 < n_ctx) ? (n_s1 + n_sgu + it0) : (it0 < n_ctx + n_sgu ? n_s1 + (it0 - n_ctx) : it0 - n_ctx - n_sgu);
    if (it < n_s1) mfma_gemm_tile<1>(RowPtr{c.ZT(), 128}, RowPtr{w1, 128}, it * 128, 0, 128, EpiStage1{c.UT()}, lds);
    else if (it < n_s1 + n_sgu) {
      const int ti = it - n_s1, g = ti & 3, row0 = (ti >> 2) * 128;
      mfma_gemm_tile<0>(RowPtr{c.WL() + WL_SGU / 2 + (size_t)g * 128 * 128, 128}, RowPtr{c.VGT() + (size_t)ti * 128 * 128, 128}, 0, 0, 128,
                        EpiSgu{c.P(), c.HY(), p.sgu_b + (li * 4 + g) * 128, row0, g}, lds);
    } else {
      const int q = it - n_s1 - n_sgu;
      mfma_gemm_tile<1>(RowPtr{c.ZTC(), 512}, RowPtr{w256, 512}, (q >> 1) * 128, (q & 1) * 128, 512, EpiCtxDft{c.P(), c.HY()}, lds);
    }
  }
}

struct BPStage2 { const bf16* W2F; int k1; DI const bf16* operator()(int n) const { return W2F + (size_t)(k1 + 64 * n) * 256; } };
struct EpiStage2 { const bf16* P; bf16* HY; int b, k1; DI void operator()(int m, int n, f32x4 v) const {
  const int row = b * S + k1 + 64 * n;
  const f32x4 fg = unpk4(*(const u32x2*)(P + (size_t)row * LDP + C_FG + m));
  f32x4 o;
#pragma unroll
  for (int i = 0; i < 4; ++i) o[i] = v[i] * 9.765625e-4f * silu(fg[i]);
  *(u32x2*)(HY + (size_t)row * D + m) = pk4(o); } };

DI void phase_odd_c(const Ctx& c, bf16* lds) {
  for (int it = blockIdx.x; it < 512; it += gridDim.x) {
    const int bk = it >> 2, b = bk >> 6, k1 = bk & 63, mt = it & 3;
    mfma_gemm_tile<1>(RowPtr{c.UT() + (size_t)bk * 512 * 256, 256}, BPStage2{c.WL() + WL_W2F / 2, k1}, mt * 128, 0, 256, EpiStage2{c.P(), c.HY(), b, k1}, lds);
  }
}


#define LAS __attribute__((address_space(3)))
#define XB_TMO      128
#define XB_XCNT(j)  (256  + 64 * (j))
#define XB_XSUB(j)  (1280 + 64 * (j))
#define XB_XGEN(j)  (2304 + 64 * (j))
#define XB_TOP      3328
#define XB_TOPGEN   3392
#define XCD_BAR_WORDS 3456
#define XB_SPIN_CAP (1u << 22)
DI unsigned xb_ld(unsigned* p) { return __hip_atomic_load(p, __ATOMIC_RELAXED, __HIP_MEMORY_SCOPE_AGENT); }
DI unsigned xb_add(unsigned* p, unsigned v) { return __hip_atomic_fetch_add(p, v, __ATOMIC_RELAXED, __HIP_MEMORY_SCOPE_AGENT); }
DI unsigned xb_xcc_id() { return (unsigned)__builtin_amdgcn_s_getreg((3 << 11) | 20) & 0xFu; }
#define XB_SPIN(cond, bar) do { unsigned _sp = 0; while (cond) { __builtin_amdgcn_s_sleep(1); \
    if ((++_sp & 255u) == 0u) { if (xb_ld(&(bar)[XB_TMO])) break; if (_sp > XB_SPIN_CAP) { atomicAdd(&(bar)[XB_TMO], 1u); break; } } } } while (0)
struct XcdBarrier { unsigned* bar; unsigned x; volatile unsigned* st; };
DI XcdBarrier xcd_barrier_post(unsigned* bar, volatile unsigned* st) {
  XcdBarrier b; b.bar = bar; b.x = xb_xcc_id(); b.st = st;
  if (threadIdx.x == 0) (void)xb_add(&bar[XB_XCNT(b.x)], 1u);
  return b;
}
DI void xcd_barrier_complete(unsigned* bar, unsigned x, unsigned& nloc, unsigned& nx) {
  const unsigned G = gridDim.x * gridDim.y * gridDim.z;
  unsigned sum, cnt, mine, sp = 0u;
  for (;;) {
    sum = 0u; cnt = 0u; mine = 0u;
#pragma unroll
    for (unsigned j = 0; j < 16; ++j) { const unsigned cc = xb_ld(&bar[XB_XCNT(j)]); sum += cc; cnt += (cc > 0u) ? 1u : 0u; mine = (j == x) ? cc : mine; }
    if (sum == G) break;
    __builtin_amdgcn_s_sleep(1);
    if ((++sp & 255u) == 0u) { if (xb_ld(&bar[XB_TMO])) break; if (sp > XB_SPIN_CAP) { atomicAdd(&bar[XB_TMO], 1u); break; } }
  }
  nloc = mine > 0u ? mine : 1u; nx = cnt > 0u ? cnt : 1u;
}
DI void xcd_barrier(const XcdBarrier& b) {
  asm volatile("s_waitcnt vmcnt(0)" ::: "memory");
  __syncthreads();
  if (threadIdx.x == 0) {
    unsigned* bar = b.bar;
    __builtin_amdgcn_s_waitcnt(0);
    unsigned nloc = b.st[0], nx = b.st[1];
    if (nloc == 0u) { xcd_barrier_complete(bar, b.x, nloc, nx); b.st[0] = nloc; b.st[1] = nx; }
    const unsigned old = xb_add(&bar[XB_XSUB(b.x)], 1u);
    const unsigned gen = old / nloc;
    if (old + 1u == (gen + 1u) * nloc) {
      __builtin_amdgcn_fence(__ATOMIC_RELEASE, "agent");
      asm volatile("s_waitcnt vmcnt(0)" ::: "memory");
      const unsigned og = xb_add(&bar[XB_TOP], 1u);
      const unsigned tg = og / nx;
      if (og + 1u == (tg + 1u) * nx) xb_add(&bar[XB_TOPGEN], 1u);
      else XB_SPIN(xb_ld(&bar[XB_TOPGEN]) == tg, bar);
      __builtin_amdgcn_fence(__ATOMIC_ACQUIRE, "agent");
      xb_add(&bar[XB_XGEN(b.x)], 1u);
      asm volatile("s_waitcnt vmcnt(0)" ::: "memory");
    } else {
      XB_SPIN(xb_ld(&bar[XB_XGEN(b.x)]) == gen, bar);
      __builtin_amdgcn_fence(__ATOMIC_ACQUIRE, "agent");
      asm volatile("s_waitcnt vmcnt(0)" ::: "memory");
    }
  }
  __syncthreads();
}

__global__ void __launch_bounds__(NT, 2) fwd_kernel(Params p) {
  cg::grid_group grid = cg::this_grid();
  __shared__ __attribute__((aligned(16))) bf16 lds[GEMM_LDS_BF16 + 256];
  float* sm = (float*)lds;
  unsigned char* ws = p.ws;
  Ctx c{p, sm};
  __shared__ unsigned bar_st[2];
  if (threadIdx.x == 0) { bar_st[0] = 0u; bar_st[1] = 0u; }
  __syncthreads();
  (void)xcd_barrier_post((unsigned*)(ws + WS_BAR), bar_st);
#define SYNC() do { XcdBarrier b_; b_.bar = (unsigned*)(p.ws + WS_BAR); b_.x = xb_xcc_id(); b_.st = bar_st; xcd_barrier(b_); } while (0)
  phase_prologue(c);
  phase_wconv_in(c, 0);
  SYNC();
  if (p.out == nullptr) grid.sync();
  phase_ln(c, -1, 0);
  SYNC();
  for (int l = 0; l < 4; ++l) {
    const int li = l >> 1;
    const int rows_in = (l <= 2) ? MT : MLAT, rows_out = (l <= 1) ? MT : MLAT;
    phase_wconv_rest(c, l);
    if ((l & 1) == 0) {
      mfma_gemm_big(RowPtr{c.HY(), D}, RowPtr{c.WL() + WL_IN / 2, D}, rows_in, 2560, D, EpiStoreP4{c.P()}, lds);
      SYNC();
      if (PROBE & 1) { mfma_gemm_big(RowPtr{c.HY(), D}, RowPtr{c.WL() + WL_IN / 2, D}, rows_in, 2560, D, EpiStoreP4{c.P()}, lds); SYNC(); }
      phase_even_b(c, l, lds);
      SYNC();
      if (PROBE & 4) { phase_even_b(c, l, lds); SYNC(); }
      phase_even_c(c, l, lds);
      SYNC();
      phase_even_d(c, l, lds);
      SYNC();
      if (PROBE & 4) { phase_even_d(c, l, lds); SYNC(); }
    } else {
      mfma_gemm_big(RowPtr{c.HY(), D}, RowPtr{c.WL() + WL_IN / 2, D}, rows_in, 2560, D, EpiStoreP4{c.P()}, lds);
      SYNC();
      if (PROBE & 1) { mfma_gemm_big(RowPtr{c.HY(), D}, RowPtr{c.WL() + WL_IN / 2, D}, rows_in, 2560, D, EpiStoreP4{c.P()}, lds); SYNC(); }
      phase_odd_a(c, l, lds);
      SYNC();
      if (PROBE & 8) { phase_odd_a(c, l, lds); SYNC(); }
      phase_odd_b(c, l, lds);
      SYNC();
      if (PROBE & 8) { phase_odd_b(c, l, lds); SYNC(); }
      phase_odd_c(c, lds);
      SYNC();
      if (PROBE & 8) { phase_odd_c(c, lds); SYNC(); }
    }
    if (l < 3) phase_wconv_in(c, l + 1);
    mfma_gemm_big(RowPtr{c.HY(), D}, RowPtr{c.WL() + WL_OUT / 2, D}, MLAT, D, D, EpiResid4{p.x, p.ctx, p.out, c.XC(), c.MOD(), l}, lds);
    if (rows_out > MLAT)
      for (int t = blockIdx.x; t < 32; t += gridDim.x)
        mfma_gemm_tile<0>(RowPtr{c.HY(), D}, RowPtr{c.WL() + WL_OUT / 2, D}, MLAT + (t >> 3) * 128, (t & 7) * 128, D, EpiResid4{p.x, p.ctx, p.out, c.XC(), c.MOD(), l}, lds);
    SYNC();
    phase_ln(c, l, l < 3 ? l + 1 : -1);
    if (l < 3) SYNC();
  }
}

extern "C" void kernel_launch(void* const* d_in, const int* in_sizes, int n_in, void* d_out, int out_size, void* d_ws, size_t ws_size,
                              hipStream_t stream) {
  static int grid_blocks = 0;
  if (!grid_blocks) {
    int dev = 0, cus = 0, per_cu = 0;
    hipGetDevice(&dev);
    hipDeviceGetAttribute(&cus, hipDeviceAttributeMultiprocessorCount, dev);
    hipOccupancyMaxActiveBlocksPerMultiprocessor(&per_cu, fwd_kernel, NT, 0);
    if (per_cu < 1) per_cu = 1;
    if (per_cu > 2) per_cu = 2;
    grid_blocks = cus * per_cu;
    if (ws_size < WS_END) fprintf(stderr, "kernel_launch: workspace too small: %zu < %zu\n", ws_size, (size_t)WS_END);
  }
  (void)hipMemsetAsync((unsigned char*)d_ws + WS_BAR, 0, WS_XC - WS_BAR, stream);
  Params p{};
  const float** pp = (const float**)&p;
  for (int i = 0; i < 21; ++i) pp[i] = (const float*)d_in[i];
  p.out = (float*)d_out; p.ws = (unsigned char*)d_ws;
  void* args[] = {&p};
  hipError_t e = hipLaunchCooperativeKernel((void*)fwd_kernel, dim3(grid_blocks), dim3(NT), args, 0, stream);
  if (e != hipSuccess) fprintf(stderr, "cooperative launch failed: %s (grid %d)\n", hipGetErrorString(e), grid_blocks);
}
```

```cpp
#include <hip/hip_runtime.h>
#include <hip/hip_cooperative_groups.h>
#include <cstdio>
#include <cstdint>
namespace cg = cooperative_groups;

typedef unsigned short bf16;
using bf16x8 = __attribute__((ext_vector_type(8))) short;
using f32x4 = __attribute__((ext_vector_type(4))) float;
using u32x4 = __attribute__((ext_vector_type(4))) unsigned;
using u32x2 = __attribute__((ext_vector_type(2))) unsigned;
using f32x16 = __attribute__((ext_vector_type(16))) float;
using s16x4 = __attribute__((ext_vector_type(4))) short;
typedef __bf16 hwbf16x2 __attribute__((ext_vector_type(2)));
#define MFMA32(a, b, c) __builtin_amdgcn_mfma_f32_32x32x16_bf16((a), (b), (c), 0, 0, 0)
#define DI __device__ __forceinline__
#define NT 256
#ifndef PROBE
#define PROBE 0
#endif

constexpr int D = 1024, NB = 2, S = 8192, L = 256, T = S + L;
constexpr int MLAT = NB * S, MCTX = NB * L, MT = MLAT + MCTX;
constexpr int LDP = 2560;
constexpr float ALPHA = 1.6817928305074290f;
constexpr float LN_EPS = 1e-6f;
constexpr int C_GQ = 0, C_GK = 256, C_GV = 512, C_GLR = 1024, C_GG = 1056, C_CQ = 1568, C_CKV = 1824, C_KR = 1952, C_MG = 1984, E_EVEN = 2496;
constexpr int C_F = 0, C_FG = 512, C_U = 1024, C_V = 1536, C_SG = 2048, E_ODD = 2560;
constexpr float QSCALE = 0.10206207261596575f * 1.4426950408889634f;

constexpr size_t al(size_t x) { return (x + 255) & ~(size_t)255; }
constexpr size_t WS_BAR = 0;
constexpr size_t WS_MOD = al(WS_BAR + 16384);
constexpr size_t WS_XC  = al(WS_MOD + 4 * 3 * 3072 * 4);
constexpr size_t WS_WL  = al(WS_XC + (size_t)MCTX * D * 4);
constexpr size_t WS_TAB = al(WS_WL + (size_t)13 * 1024 * 1024);
constexpr size_t WS_HY  = al(WS_TAB + (size_t)2 * 1024 * 1024);
constexpr size_t WS_P   = al(WS_HY + (size_t)MT * D * 2);
constexpr size_t WS_U   = al(WS_P + (size_t)MT * LDP * 2);
constexpr size_t WS_Q   = WS_U;
constexpr size_t WS_QC  = al(WS_Q + (size_t)NB * 8 * S * 96 * 2);
constexpr size_t WS_K   = al(WS_QC + (size_t)NB * 8 * L * 96 * 2);
constexpr size_t WS_VT  = al(WS_K + (size_t)NB * 8 * T * 96 * 2);
constexpr size_t WS_G   = al(WS_VT + (size_t)NB * 8 * 64 * T * 2);
constexpr size_t WS_DEC = al(WS_G + (size_t)4 * 132 * 4 * 8192 * 2);
static_assert(WS_DEC + (size_t)4 * 132 * 4 * 64 * 4 <= WS_G + (size_t)MT * 512 * 6, "DS/DEC");
constexpr size_t WS_OG  = al(WS_G + (size_t)MT * 512 * 2);
constexpr size_t WS_END_EVEN = al(WS_OG + (size_t)MT * 512 * 4);
constexpr size_t WS_ZN  = WS_U;
constexpr size_t WS_VG  = al(WS_ZN + (size_t)MT * 1024 * 2);
constexpr size_t WS_ZT  = WS_U;
constexpr size_t WS_ZTC = al(WS_ZT + (size_t)NB * 512 * 128 * 128 * 2);
constexpr size_t WS_UT  = al(WS_ZTC + (size_t)NB * 512 * 512 * 2);
constexpr size_t WS_VGT = al(WS_UT + (size_t)NB * 64 * 512 * 256 * 2);
constexpr size_t WS_END_ODD = al(WS_VGT + (size_t)528 * 128 * 128 * 2);
constexpr size_t WS_END = WS_END_EVEN > WS_END_ODD ? WS_END_EVEN : WS_END_ODD;
static_assert(WS_END <= (size_t)256 * 1024 * 1024, "workspace");
constexpr size_t WL_IN = 0, WL_OUT = (size_t)2560 * 1024 * 2, WL_UQ = WL_OUT + (size_t)1024 * 1024 * 2, WL_UKV = WL_UQ + (size_t)768 * 256 * 2,
                 WL_SGU = WL_UKV + (size_t)1024 * 128 * 2, WL_END = WL_SGU + (size_t)4 * 128 * 128 * 2;
constexpr size_t WL_W2F = (size_t)8448 * 1024;
static_assert(WL_END <= WL_W2F && WL_W2F + (size_t)8192 * 256 * 2 <= (size_t)13 * 1024 * 1024, "WL");
constexpr size_t TBB_CS128 = (size_t)1280 * 1024, TBB_W1 = TBB_CS128 + 256 * 128 * 2, TBB_W256 = TBB_W1 + 128 * 128 * 2, TBB_END = TBB_W256 + 256 * 512 * 2;
static_assert(TBB_END <= (size_t)2 * 1024 * 1024, "TAB");
constexpr int TB_C128 = 0, TB_S128 = 128, TB_C8K = 256, TB_S8K = 256 + 8192, TB_ROPE = 256 + 16384;

struct Params {
  const float *x, *c, *ctx, *c_ctx, *ada_w, *ada_b, *post_g, *post_b, *even_w_in, *gla_w2, *gla_b, *gla_norm_g,
      *q_norm_g, *w_uq, *kv_norm_g, *w_ukv, *even_w_out, *odd_w_in, *sgu_w, *sgu_b, *odd_w_out;
  float* out; unsigned char* ws;
};

DI int otid() { int t = threadIdx.x; asm volatile("" : "+v"(t)); return t; }
DI float bf2f(bf16 v) { return __uint_as_float(((unsigned)v) << 16); }
DI bf16 f2bf(float f) { unsigned u = __float_as_uint(f); u += 0x7fffu + ((u >> 16) & 1u); return (bf16)(u >> 16); }
DI float silu(float x) { return x * __builtin_amdgcn_rcpf(1.f + __expf(-x)); }
DI float erf_as(float x) {
  const float ax = fabsf(x);
  const float t = __builtin_amdgcn_rcpf(1.f + 0.3275911f * ax);
  const float poly = t * (0.254829592f + t * (-0.284496736f + t * (1.421413741f + t * (-1.453152027f + t * 1.061405429f))));
  const float y = 1.f - poly * __builtin_amdgcn_exp2f(-1.4426950408889634f * ax * ax);
  return copysignf(y, x);
}
DI float gelu(float x) { return 0.5f * x * (1.f + erf_as(x * 0.70710678118654752f)); }
DI float logsigmoid(float z) { return fminf(z, 0.f) - log1pf(__expf(-fabsf(z))); }
DI float logsigmoid_fast(float z) { return -0.6931471805599453f * __builtin_amdgcn_logf(1.f + __builtin_amdgcn_exp2f(-1.4426950408889634f * fmaxf(z, -80.f))); }
template <int CTRL> DI float dpp_add(float v) { return v + __builtin_bit_cast(float, __builtin_amdgcn_update_dpp(0, __builtin_bit_cast(int, v), CTRL, 0xf, 0xf, false)); }
DI float wave_sum(float v) {
  v = dpp_add<0x128>(v); v = dpp_add<0x124>(v); v = dpp_add<0x122>(v); v = dpp_add<0x121>(v);
  v += __shfl_xor(v, 16);
  const unsigned u = __float_as_uint(v);
  auto r = __builtin_amdgcn_permlane32_swap(u, u, false, false);
  return __uint_as_float(r[0]) + __uint_as_float(r[1]);
}
DI int mod_row(int row) { return row < MLAT ? (row >> 13) : 2; }

struct Ctx {
  Params p;
  float* sm;
  DI float* MOD() const { return (float*)(p.ws + WS_MOD); }
  DI float* XC() const { return (float*)(p.ws + WS_XC); }
  DI float* TAB() const { return (float*)(p.ws + WS_TAB); }
  DI bf16* WL() const { return (bf16*)(p.ws + WS_WL); }
  DI bf16* HY() const { return (bf16*)(p.ws + WS_HY); }
  DI bf16* P() const { return (bf16*)(p.ws + WS_P); }
  DI bf16* Q() const { return (bf16*)(p.ws + WS_Q); }
  DI bf16* QC() const { return (bf16*)(p.ws + WS_QC); }
  DI bf16* K() const { return (bf16*)(p.ws + WS_K); }
  DI bf16* VT() const { return (bf16*)(p.ws + WS_VT); }
  DI bf16* G() const { return (bf16*)(p.ws + WS_G); }
  DI float* DEC() const { return (float*)(p.ws + WS_DEC); }
  DI bf16* ZT() const { return (bf16*)(p.ws + WS_ZT); }
  DI bf16* ZTC() const { return (bf16*)(p.ws + WS_ZTC); }
  DI bf16* UT() const { return (bf16*)(p.ws + WS_UT); }
  DI bf16* VGT() const { return (bf16*)(p.ws + WS_VGT); }
  DI float* xrow(int row) const { return row < MLAT ? p.out + (size_t)row * D : XC() + (size_t)(row - MLAT) * D; }
  DI const float* xin(int row) const { return row < MLAT ? p.x + (size_t)row * D : p.ctx + (size_t)(row - MLAT) * D; }
};

DI void phase_prologue(const Ctx& c, int item_lo, int item_hi, bool tables) {
  const Params& p = c.p;
  const int tid = otid();
  for (int i = tid; i < 3072; i += NT) { const float v = (i < 2048) ? p.c[i] : p.c_ctx[i - 2048]; c.sm[i] = silu(v); }
  __syncthreads();
  for (int item = item_lo + blockIdx.x; item < item_hi; item += gridDim.x) {
    const int l = item / 192, rem = item % 192, cb = rem >> 4, ks = rem & 15, col = cb * 256 + tid;
    const float* w = p.ada_w + ((size_t)l * D + ks * 64) * 3072 + col;
    float a0 = 0.f, a1 = 0.f, a2 = 0.f;
#pragma unroll 8
    for (int d = 0; d < 64; ++d) { const float wv = w[(size_t)d * 3072]; a0 += c.sm[ks * 64 + d] * wv; a1 += c.sm[1024 + ks * 64 + d] * wv; a2 += c.sm[2048 + ks * 64 + d] * wv; }
    if (ks == 0) { const float bb = p.ada_b[l * 3072 + col]; a0 += bb; a1 += bb; a2 += bb; }
    atomicAdd(c.MOD() + (l * 3 + 0) * 3072 + col, a0); atomicAdd(c.MOD() + (l * 3 + 1) * 3072 + col, a1); atomicAdd(c.MOD() + (l * 3 + 2) * 3072 + col, a2);
  }
  __syncthreads();
  if (!tables) return;
  const int gt = blockIdx.x * NT + tid, gs = gridDim.x * NT;
  for (int i = gt; i < 128; i += gs) { float sv, cv; sincospif(2.f * (float)i / 128.f, &sv, &cv); c.TAB()[TB_C128 + i] = cv; c.TAB()[TB_S128 + i] = sv; }
  for (int i = gt; i < 8192; i += gs) { float sv, cv; sincospif(2.f * (float)i / 8192.f, &sv, &cv); c.TAB()[TB_C8K + i] = cv; c.TAB()[TB_S8K + i] = sv; }
  for (int i = gt; i < 8192 * 16; i += gs) {
    const int t = i >> 4, f = i & 15;
    const float pos = (f < 8) ? (float)(t >> 6) : (float)(t & 63);
    const float inv = powf(10000.f, -(float)(f & 7) / 8.f);
    const float ang = pos * inv;
    c.TAB()[TB_ROPE + i * 2] = cosf(ang); c.TAB()[TB_ROPE + i * 2 + 1] = sinf(ang);
  }
  {
    bf16* cs128 = (bf16*)((unsigned char*)c.TAB() + TBB_CS128);
    for (int i = gt; i < 256 * 128; i += gs) { const int n = i >> 7, cc = i & 127, ri = n >> 7, j = n & 127; float sv, cv; sincospif(2.f * (float)((j * cc) & 127) / 128.f, &sv, &cv); cs128[i] = f2bf(ri ? -sv : cv); }
    bf16* w1 = (bf16*)((unsigned char*)c.TAB() + TBB_W1);
    for (int i = gt; i < 128 * 128; i += gs) {
      const int n = i >> 7, k = i & 127, ro = n >> 6, k1 = n & 63, ri = k >> 6, t1 = k & 63; float sv, cv; sincospif(2.f * (float)((k1 * t1) & 63) / 64.f, &sv, &cv);
      w1[i] = f2bf(ro == ri ? cv : (ro ? -sv : sv));
    }
    bf16* w256 = (bf16*)((unsigned char*)c.TAB() + TBB_W256);
    for (int i = gt; i < 256 * 512; i += gs) { const int k = i >> 9, kk = i & 511, ri = kk >> 8, t = kk & 255; float sv, cv; sincospif(2.f * (float)((k * t) & 255) / 256.f, &sv, &cv); w256[i] = f2bf(ri ? sv : cv); }
    bf16* w2f = c.WL() + WL_W2F / 2;
    for (int i = gt; i < 8192 * 256; i += gs) { const int k = i >> 8, kk = i & 255, ri = kk >> 7, t2 = kk & 127; float sv, cv; sincospif(2.f * (float)((k * t2) & 8191) / 8192.f, &sv, &cv); w2f[i] = f2bf(ri ? sv : cv); }
  }
}

DI void ln_row(const Ctx& c, int row, int l_post, int l_next, int lane) {
  const Params& p = c.p;
    const bool lat = row < MLAT;
    const bool do_post = (l_post >= 0) && (lat || l_post <= 1);
    const bool do_h = (l_next >= 0) && (lat || l_next <= 2);
    if (!do_post && !do_h) return;
    if (l_post >= 0 && !do_post) return;
    const float* src = (l_post < 0) ? c.xin(row) : c.xrow(row);
    float v[16];
#pragma unroll
    for (int i = 0; i < 4; ++i) { const float4 t = *(const float4*)(src + i * 256 + lane * 4); v[i * 4] = t.x; v[i * 4 + 1] = t.y; v[i * 4 + 2] = t.z; v[i * 4 + 3] = t.w; }
    if (do_post) {
      float s = 0.f;
#pragma unroll
      for (int i = 0; i < 16; ++i) s += v[i];
      const float mean = wave_sum(s) * (1.f / D);
      float q = 0.f;
#pragma unroll
      for (int i = 0; i < 16; ++i) { v[i] -= mean; q += v[i] * v[i]; }
      const float rstd = rsqrtf(wave_sum(q) * (1.f / D) + LN_EPS);
      float* dst = c.xrow(row);
#pragma unroll
      for (int i = 0; i < 4; ++i) {
        const int col = i * 256 + lane * 4;
        const float4 g = *(const float4*)(p.post_g + l_post * D + col), b = *(const float4*)(p.post_b + l_post * D + col);
        v[i * 4] = v[i * 4] * rstd * g.x + b.x; v[i * 4 + 1] = v[i * 4 + 1] * rstd * g.y + b.y;
        v[i * 4 + 2] = v[i * 4 + 2] * rstd * g.z + b.z; v[i * 4 + 3] = v[i * 4 + 3] * rstd * g.w + b.w;
        *(float4*)(dst + col) = make_float4(v[i * 4], v[i * 4 + 1], v[i * 4 + 2], v[i * 4 + 3]);
      }
    }
    if (do_h) {
      float s = 0.f;
#pragma unroll
      for (int i = 0; i < 16; ++i) s += v[i];
      const float mean = wave_sum(s) * (1.f / D);
      float q = 0.f;
#pragma unroll
      for (int i = 0; i < 16; ++i) { v[i] -= mean; q += v[i] * v[i]; }
      const float rstd = rsqrtf(wave_sum(q) * (1.f / D) + LN_EPS);
      const float* md = c.MOD() + (l_next * 3 + mod_row(row)) * 3072;
      bf16* dst = c.HY() + (size_t)row * D;
#pragma unroll
      for (int i = 0; i < 4; ++i) {
        const int col = i * 256 + lane * 4;
        const float4 sh = *(const float4*)(md + col), sc = *(const float4*)(md + 1024 + col);
        const float h0 = v[i * 4] * rstd * (1.f + sc.x) + sh.x, h1 = v[i * 4 + 1] * rstd * (1.f + sc.y) + sh.y;
        const float h2 = v[i * 4 + 2] * rstd * (1.f + sc.z) + sh.z, h3 = v[i * 4 + 3] * rstd * (1.f + sc.w) + sh.w;
        uint2 pk; pk.x = (unsigned)f2bf(h0) | ((unsigned)f2bf(h1) << 16); pk.y = (unsigned)f2bf(h2) | ((unsigned)f2bf(h3) << 16);
        *(uint2*)(dst + col) = pk;
      }
    }
}
DI void phase_ln(const Ctx& c, int l_post, int l_next) {
  const int tid = otid(), lane = tid & 63;
  const int wv = (blockIdx.x * NT + tid) >> 6, nw = (gridDim.x * NT) >> 6;
  for (int row = wv; row < MT; row += 2 * nw) { ln_row(c, row, l_post, l_next, lane); if (row + nw < MT) ln_row(c, row + nw, l_post, l_next, lane); }
}

constexpr int GEMM_LDS_BF16 = 2 * 2 * 128 * 72;
template <int TRANS, class AP, class BP, class Epi>
DI void mfma_gemm_tile(const AP& aptr, const BP& bptr, int m0, int n0, int K, const Epi& epi, bf16* lds) {
  const int tid = otid(), lane = tid & 63, wave = __builtin_amdgcn_readfirstlane(tid >> 6);
  const int wm = (wave >> 1) * 64, wn = (wave & 1) * 64;
  const int lr = tid >> 3, lc = ((tid & 7) ^ (lr & 7)) * 8;
  const int l16 = lane & 15, lq = lane >> 4;
  const bf16* ap[4]; const bf16* bp[4];
#pragma unroll
  for (int i = 0; i < 4; ++i) { ap[i] = aptr(m0 + lr + 32 * i) + lc; bp[i] = bptr(n0 + lr + 32 * i) + lc; }
  f32x4 acc[4][4];
#pragma unroll
  for (int i = 0; i < 4; ++i)
#pragma unroll
    for (int j = 0; j < 4; ++j) acc[i][j] = f32x4{0.f, 0.f, 0.f, 0.f};
  const int nk = K >> 6;
#define GEMM_STAGE(buf, ks) do { bf16* As_ = lds + (buf) * (2 * 128 * 64); bf16* Bs_ = As_ + 128 * 64; \
    _Pragma("unroll") for (int i = 0; i < 4; ++i) { \
      __builtin_amdgcn_global_load_lds((const unsigned*)(ap[i] + (ks) * 64), (__attribute__((address_space(3))) unsigned*)(As_ + (i * 256 + wave * 64) * 8), 16, 0, 0); \
      __builtin_amdgcn_global_load_lds((const unsigned*)(bp[i] + (ks) * 64), (__attribute__((address_space(3))) unsigned*)(Bs_ + (i * 256 + wave * 64) * 8), 16, 0, 0); } } while (0)
  GEMM_STAGE(0, 0);
  if (nk > 1) GEMM_STAGE(1, 1);
  const unsigned lbase = (unsigned)(size_t)lds;
  const unsigned sw0 = (unsigned)(((lq ^ (l16 & 7)) * 8) * 2), sw1 = (unsigned)((((4 + lq) ^ (l16 & 7)) * 8) * 2);
  const unsigned a_row = (unsigned)((wm + l16) * 128), b_row = (unsigned)((128 * 64 + (wn + l16) * 64) * 2);
#define LDSR(dst, addr, off) asm volatile("ds_read_b128 %0, %1 offset:%2" : "=&v"(dst) : "v"(addr), "n"(off))
  for (int ks = 0; ks < nk; ++ks) {
    if (ks + 1 < nk) asm volatile("s_waitcnt vmcnt(8)\n\ts_barrier" ::: "memory");
    else asm volatile("s_waitcnt vmcnt(0)\n\ts_barrier" ::: "memory");
    const unsigned sb_ = lbase + (unsigned)((ks & 1) * (2 * 128 * 64) * 2);
    const unsigned a0 = sb_ + a_row + sw0, a1 = sb_ + a_row + sw1, b0 = sb_ + b_row + sw0, b1 = sb_ + b_row + sw1;
    bf16x8 af[2][4], bfr[2][4];
    LDSR(af[0][0], a0, 0); LDSR(af[0][1], a0, 2048); LDSR(af[0][2], a0, 4096); LDSR(af[0][3], a0, 6144);
    LDSR(bfr[0][0], b0, 0); LDSR(bfr[0][1], b0, 2048); LDSR(bfr[0][2], b0, 4096); LDSR(bfr[0][3], b0, 6144);
    LDSR(af[1][0], a1, 0); LDSR(af[1][1], a1, 2048); LDSR(af[1][2], a1, 4096); LDSR(af[1][3], a1, 6144);
    LDSR(bfr[1][0], b1, 0); LDSR(bfr[1][1], b1, 2048); LDSR(bfr[1][2], b1, 4096); LDSR(bfr[1][3], b1, 6144);
    asm volatile("s_waitcnt lgkmcnt(0)" : "+v"(af[0][0]), "+v"(af[0][1]), "+v"(af[0][2]), "+v"(af[0][3]), "+v"(bfr[0][0]), "+v"(bfr[0][1]), "+v"(bfr[0][2]), "+v"(bfr[0][3]),
                 "+v"(af[1][0]), "+v"(af[1][1]), "+v"(af[1][2]), "+v"(af[1][3]), "+v"(bfr[1][0]), "+v"(bfr[1][1]), "+v"(bfr[1][2]), "+v"(bfr[1][3]) : : "memory");
    if (ks + 2 < nk) {
      asm volatile("s_barrier" ::: "memory");
      GEMM_STAGE(ks & 1, ks + 2);
    }
#pragma unroll
    for (int kk = 0; kk < 2; ++kk)
#pragma unroll
      for (int i = 0; i < 4; ++i)
#pragma unroll
        for (int j = 0; j < 4; ++j)
          acc[i][j] = TRANS ? __builtin_amdgcn_mfma_f32_16x16x32_bf16(af[kk][i], bfr[kk][j], acc[i][j], 0, 0, 0)
                            : __builtin_amdgcn_mfma_f32_16x16x32_bf16(bfr[kk][j], af[kk][i], acc[i][j], 0, 0, 0);
  }
#undef LDSR
#undef GEMM_STAGE
#pragma unroll
  for (int i = 0; i < 4; ++i)
#pragma unroll
    for (int j = 0; j < 4; ++j) {
      if (TRANS) epi(m0 + wm + 16 * i + 4 * lq, n0 + wn + 16 * j + l16, acc[i][j]);
      else epi(m0 + wm + 16 * i + l16, n0 + wn + 16 * j + 4 * lq, acc[i][j]);
    }
  asm volatile("s_waitcnt vmcnt(0)" ::: "memory");
  __syncthreads();
}

template <class F>
DI void xcd_items(int total, const F& f) {
  const int G = gridDim.x;
  if ((G & 7) == 0 && (total & 7) == 0) {
    const int x = blockIdx.x & 7, j = blockIdx.x >> 3, per = total >> 3, gl = G >> 3;
    for (int q = j; q < per; q += gl) f(x * per + q);
  } else {
    for (int t = blockIdx.x; t < total; t += G) f(t);
  }
}
struct RowPtr { const bf16* base; int ld; DI const bf16* operator()(int r) const { return base + (size_t)r * ld; } };

template <int TRANS, class AP, class BP, class Epi>
DI void mfma_gemm(const AP& aptr, const BP& bptr, int M, int N, int K, const Epi& epi, bf16* lds) {
  const int tn = N / 128, tiles = (M / 128) * tn;
  for (int t = blockIdx.x; t < tiles; t += gridDim.x) mfma_gemm_tile<TRANS>(aptr, bptr, (t / tn) * 128, (t % tn) * 128, K, epi, lds);
}


constexpr int BG_STAGE = (256 + 128) * 32;
static_assert(3 * BG_STAGE <= GEMM_LDS_BF16, "big GEMM LDS");
template <class AP, class BP, class Epi>
DI void mfma_gemm_big_tile(const AP& aptr, const BP& bptr, int m0, int n0, int K, const Epi& epi, bf16* lds) {
  const int tid = otid(), lane = tid & 63, wave = __builtin_amdgcn_readfirstlane(tid >> 6);
  const int wm = (wave >> 1) * 128, wn = (wave & 1) * 64;
  const int l16 = lane & 15, lq = lane >> 4;
  const int lrow = tid >> 2, lcol = ((tid & 3) ^ ((-(tid >> 4)) & 3)) * 8;
  const bf16* ap[4]; const bf16* bp[2];
#pragma unroll
  for (int i = 0; i < 4; ++i) ap[i] = aptr(m0 + lrow + 64 * i) + lcol;
#pragma unroll
  for (int i = 0; i < 2; ++i) bp[i] = bptr(n0 + lrow + 64 * i) + lcol;
  f32x4 acc[8][4];
#pragma unroll
  for (int i = 0; i < 8; ++i)
#pragma unroll
    for (int j = 0; j < 4; ++j) acc[i][j] = f32x4{0.f, 0.f, 0.f, 0.f};
  const int nk = K >> 5;
#define BG_ISSUE(buf, ks) do { bf16* As_ = lds + (buf) * BG_STAGE; bf16* Bs_ = As_ + 256 * 32; \
    _Pragma("unroll") for (int i = 0; i < 4; ++i) \
      __builtin_amdgcn_global_load_lds((const unsigned*)(ap[i] + (ks) * 32), (__attribute__((address_space(3))) unsigned*)(As_ + (i * 256 + wave * 64) * 8), 16, 0, 0); \
    _Pragma("unroll") for (int i = 0; i < 2; ++i) \
      __builtin_amdgcn_global_load_lds((const unsigned*)(bp[i] + (ks) * 32), (__attribute__((address_space(3))) unsigned*)(Bs_ + (i * 256 + wave * 64) * 8), 16, 0, 0); } while (0)
  BG_ISSUE(0, 0);
  BG_ISSUE(1, 1);
  asm volatile("s_waitcnt vmcnt(6)\n\ts_barrier" ::: "memory");
  const unsigned lbase = (unsigned)(size_t)lds;
  const unsigned a_off = (unsigned)(((wm + l16) * 32 + (lq ^ ((-(l16 >> 2)) & 3)) * 8) * 2);
  const unsigned b_off = (unsigned)((256 * 32 + (wn + l16) * 32 + (lq ^ ((-(l16 >> 2)) & 3)) * 8) * 2);
#define LDSR(dst, addr, off) asm volatile("ds_read_b128 %0, %1 offset:%2" : "=&v"(dst) : "v"(addr), "n"(off))
  int cur = 0, nxt = 2;
  for (int ks = 0; ks < nk; ++ks) {
    if (ks + 2 < nk) BG_ISSUE(nxt, ks + 2);
    const unsigned sa = lbase + (unsigned)(cur * BG_STAGE * 2) + a_off, sb = lbase + (unsigned)(cur * BG_STAGE * 2) + b_off;
    bf16x8 af[8], bfr[4];
    LDSR(bfr[0], sb, 0); LDSR(bfr[1], sb, 1024); LDSR(bfr[2], sb, 2048); LDSR(bfr[3], sb, 3072);
    LDSR(af[0], sa, 0); LDSR(af[1], sa, 1024); LDSR(af[2], sa, 2048); LDSR(af[3], sa, 3072);
    LDSR(af[4], sa, 4096); LDSR(af[5], sa, 5120); LDSR(af[6], sa, 6144); LDSR(af[7], sa, 7168);
    asm volatile("s_waitcnt lgkmcnt(0)" : "+v"(af[0]), "+v"(af[1]), "+v"(af[2]), "+v"(af[3]), "+v"(af[4]), "+v"(af[5]), "+v"(af[6]), "+v"(af[7]),
                 "+v"(bfr[0]), "+v"(bfr[1]), "+v"(bfr[2]), "+v"(bfr[3]) : : "memory");
#pragma unroll
    for (int i = 0; i < 8; ++i)
#pragma unroll
      for (int j = 0; j < 4; ++j) acc[i][j] = __builtin_amdgcn_mfma_f32_16x16x32_bf16(bfr[j], af[i], acc[i][j], 0, 0, 0);
    if (ks + 2 < nk) asm volatile("s_waitcnt vmcnt(6)\n\ts_barrier" ::: "memory");
    else asm volatile("s_waitcnt vmcnt(0)\n\ts_barrier" ::: "memory");
    cur = (cur == 2) ? 0 : cur + 1; nxt = (nxt == 2) ? 0 : nxt + 1;
  }
#undef LDSR
#undef BG_ISSUE
#pragma unroll
  for (int i = 0; i < 8; ++i)
#pragma unroll
    for (int j = 0; j < 4; ++j) epi(m0 + wm + 16 * i + l16, n0 + wn + 16 * j + 4 * lq, acc[i][j]);
  asm volatile("s_waitcnt vmcnt(0)" ::: "memory");
  __syncthreads();
}
template <class AP, class BP, class Epi>
DI void mfma_gemm_big(const AP& aptr, const BP& bptr, int M, int N, int K, const Epi& epi, bf16* lds) {
  const int tn = N / 128, tiles = (M / 256) * tn;
  xcd_items(tiles, [&](int t) { mfma_gemm_big_tile(aptr, bptr, (t / tn) * 256, (t % tn) * 128, K, epi, lds); });
}

DI unsigned pk2(float lo, float hi) { hwbf16x2 v = {(__bf16)lo, (__bf16)hi}; return __builtin_bit_cast(unsigned, v); }
DI u32x2 pk4(f32x4 v) { return u32x2{pk2(v[0], v[1]), pk2(v[2], v[3])}; }
DI f32x4 unpk4(u32x2 u) { return f32x4{__uint_as_float(u[0] << 16), __uint_as_float(u[0] & 0xffff0000u), __uint_as_float(u[1] << 16), __uint_as_float(u[1] & 0xffff0000u)}; }
struct EpiStoreP4 { bf16* P; DI void operator()(int m, int n, f32x4 v) const { uint2 u; u.x = pk2(v[0], v[1]); u.y = pk2(v[2], v[3]); *(uint2*)(P + (size_t)m * LDP + n) = u; } };
struct EpiResid4 {
  const float* xin_lat; const float* xin_ctx; float* x_lat; float* x_ctx; const float* MOD; int l;
  DI void operator()(int m, int n, f32x4 v) const {
    const bool lat = m < MLAT;
    const size_t off = lat ? (size_t)m * D + n : (size_t)(m - MLAT) * D + n;
    float* xp = (lat ? x_lat : x_ctx) + off;
    const float4 xo = (l == 0) ? *(const float4*)((lat ? xin_lat : xin_ctx) + off) : *(const float4*)xp;
    const float4 g = *(const float4*)(MOD + (l * 3 + mod_row(m)) * 3072 + 2048 + n);
    *(float4*)xp = make_float4(ALPHA * xo.x + g.x * v[0], ALPHA * xo.y + g.y * v[1], ALPHA * xo.z + g.z * v[2], ALPHA * xo.w + g.w * v[3]);
  }
};

DI void wconv_t(const float* W, int K, int N, int Npad, bf16* Wt) {
  const size_t gt = (size_t)blockIdx.x * NT + otid(), gs = (size_t)gridDim.x * NT;
  const int kc = K >> 3;
  for (size_t i = gt; i < (size_t)Npad * kc; i += gs) {
    const int n = (int)(i % Npad), k0 = (int)(i / Npad) * 8;
    uint4 u = make_uint4(0, 0, 0, 0);
    if (n < N) {
      const float* w = W + (size_t)k0 * N + n;
      u.x = pk2(w[0], w[(size_t)N]); u.y = pk2(w[(size_t)2 * N], w[(size_t)3 * N]);
      u.z = pk2(w[(size_t)4 * N], w[(size_t)5 * N]); u.w = pk2(w[(size_t)6 * N], w[(size_t)7 * N]);
    }
    *(uint4*)(Wt + (size_t)n * K + k0) = u;
  }
}
DI void phase_wconv_in(const Ctx& c, int l) {
  const Params& p = c.p; const int li = l >> 1;
  if ((l & 1) == 0) wconv_t(p.even_w_in + (size_t)li * D * E_EVEN, D, E_EVEN, 2560, c.WL() + WL_IN / 2);
  else wconv_t(p.odd_w_in + (size_t)li * D * E_ODD, D, E_ODD, 2560, c.WL() + WL_IN / 2);
}
DI void phase_wconv_rest(const Ctx& c, int l) {
  const Params& p = c.p; const int li = l >> 1;
  bf16* WL = c.WL();
  if ((l & 1) == 0) {
    wconv_t(p.even_w_out + (size_t)li * D * D, D, D, D, WL + WL_OUT / 2);
    const size_t gt = (size_t)blockIdx.x * NT + otid(), gs = (size_t)gridDim.x * NT;
    for (size_t i = gt; i < (size_t)768 * 32; i += gs) {
      const int n = (int)(i % 768), k0 = (int)(i / 768) * 8, h = n / 96, j = n - h * 96;
      const int src = (j < 64) ? n : h * 96 + 64 + 16 * ((j - 64) & 1) + ((j - 64) >> 1);
      const float* w = p.w_uq + (size_t)li * 256 * 768 + (size_t)k0 * 768 + src; const float* g = p.q_norm_g + li * 256 + k0;
      u32x4 u;
      u[0] = pk2(w[0] * g[0], w[768] * g[1]); u[1] = pk2(w[2 * 768] * g[2], w[3 * 768] * g[3]);
      u[2] = pk2(w[4 * 768] * g[4], w[5 * 768] * g[5]); u[3] = pk2(w[6 * 768] * g[6], w[7 * 768] * g[7]);
      *(u32x4*)(WL + WL_UQ / 2 + (size_t)n * 256 + k0) = u;
    }
    for (size_t i = gt; i < (size_t)1024 * 16; i += gs) {
      const int n = (int)(i % 1024), k0 = (int)(i / 1024) * 8, part = n >> 9, nn = n & 511, h = nn >> 6, j = nn & 63;
      const int src = h * 128 + part * 64 + j;
      const float* w = p.w_ukv + (size_t)li * 128 * 1024 + (size_t)k0 * 1024 + src; const float* g = p.kv_norm_g + li * 128 + k0;
      u32x4 u;
      u[0] = pk2(w[0] * g[0], w[1024] * g[1]); u[1] = pk2(w[2 * 1024] * g[2], w[3 * 1024] * g[3]);
      u[2] = pk2(w[4 * 1024] * g[4], w[5 * 1024] * g[5]); u[3] = pk2(w[6 * 1024] * g[6], w[7 * 1024] * g[7]);
      *(u32x4*)(WL + WL_UKV / 2 + (size_t)n * 128 + k0) = u;
    }
  } else {
    wconv_t(p.odd_w_out + (size_t)li * D * D, D, D, D, WL + WL_OUT / 2);
    const size_t gt = (size_t)blockIdx.x * NT + otid(), gs = (size_t)gridDim.x * NT;
    for (size_t i = gt; i < (size_t)4 * 128 * 128; i += gs) WL[WL_SGU / 2 + i] = f2bf(p.sgu_w[(size_t)li * 4 * 128 * 128 + i]);
  }
}


template <class Epi>
DI void naive_gemm(const bf16* A, int lda, const float* B, int ldb, int M, int N, int K, const Epi& epi, float* sm) {
  float* As = sm;
  float* Bs = sm + 16 * 64;
  const int tid = otid(), ty = tid >> 4, tx = tid & 15;
  const int tiles_n = N / 64, tiles = (M / 64) * tiles_n;
  for (int tile = blockIdx.x; tile < tiles; tile += gridDim.x) {
    const int m0 = (tile / tiles_n) * 64, n0 = (tile % tiles_n) * 64;
    float acc[4][4];
#pragma unroll
    for (int i = 0; i < 4; ++i)
#pragma unroll
      for (int j = 0; j < 4; ++j) acc[i][j] = 0.f;
    for (int k0 = 0; k0 < K; k0 += 16) {
      {
        const int r = tid >> 2, kk = (tid & 3) * 4;
        const uint2 u = *(const uint2*)(A + (size_t)(m0 + r) * lda + k0 + kk);
        As[(kk + 0) * 64 + r] = bf2f((bf16)(u.x & 0xffff)); As[(kk + 1) * 64 + r] = bf2f((bf16)(u.x >> 16));
        As[(kk + 2) * 64 + r] = bf2f((bf16)(u.y & 0xffff)); As[(kk + 3) * 64 + r] = bf2f((bf16)(u.y >> 16));
        const int kb = tid >> 4, nb = (tid & 15) * 4;
        *(float4*)(Bs + kb * 64 + nb) = *(const float4*)(B + (size_t)(k0 + kb) * ldb + n0 + nb);
      }
      __syncthreads();
#pragma unroll
      for (int k = 0; k < 16; ++k) {
        const float4 a = *(const float4*)(As + k * 64 + ty * 4), b = *(const float4*)(Bs + k * 64 + tx * 4);
        const float av[4] = {a.x, a.y, a.z, a.w}, bv[4] = {b.x, b.y, b.z, b.w};
#pragma unroll
        for (int i = 0; i < 4; ++i)
#pragma unroll
          for (int j = 0; j < 4; ++j) acc[i][j] += av[i] * bv[j];
      }
      __syncthreads();
    }
#pragma unroll
    for (int i = 0; i < 4; ++i)
#pragma unroll
      for (int j = 0; j < 4; ++j) epi(m0 + ty * 4 + i, n0 + tx * 4 + j, acc[i][j]);
  }
}

struct EpiStoreP { bf16* P; DI void operator()(int m, int n, float v) const { P[(size_t)m * LDP + n] = f2bf(v); } };
struct EpiResid {
  const float* xin_lat; const float* xin_ctx; float* x_lat; float* x_ctx; const float* MOD; int l;
  DI void operator()(int m, int n, float v) const {
    const bool lat = m < MLAT;
    const size_t off = lat ? (size_t)m * D + n : (size_t)(m - MLAT) * D + n;
    float* xp = (lat ? x_lat : x_ctx) + off;
    const float xo = (l == 0) ? (lat ? xin_lat : xin_ctx)[off] : *xp;
    const float g = MOD[(l * 3 + mod_row(m)) * 3072 + 2048 + n];
    *xp = ALPHA * xo + g * v;
  }
};

constexpr int AK_LD = 104, AV_LD = 68;
constexpr int ATT_BUF = 64 * AK_LD + 64 * AV_LD;
DI float xhalf_max(float x) {
  const unsigned u = __float_as_uint(x);
  auto r = __builtin_amdgcn_permlane32_swap(u, u, false, false);
  return fmaxf(__uint_as_float(r[0]), __uint_as_float(r[1]));
}
DI float xhalf_sum(float x) {
  const unsigned u = __float_as_uint(x);
  auto r = __builtin_amdgcn_permlane32_swap(u, u, false, false);
  return __uint_as_float(r[0]) + __uint_as_float(r[1]);
}
DI void attn_item(const Ctx& c, int item, bf16* lds) {
  const int tid = otid(), lane = tid & 63, wave = tid >> 6, r = lane & 31, hh = lane >> 5;
  int bh, nk, rowbase; const bf16* Qb;
  if (item < 512) { bh = item >> 5; const int q0 = (item & 31) * 256; nk = T; Qb = c.Q() + ((size_t)bh * S + q0) * 96; rowbase = (bh >> 3) * S + q0; }
  else { bh = item - 512; nk = L; Qb = c.QC() + (size_t)bh * L * 96; rowbase = MLAT + (bh >> 3) * L; }
  const int h = bh & 7;
  const bf16* Kb = c.K() + (size_t)bh * T * 96;
  const bf16* Vb = c.VT() + (size_t)bh * 64 * T;
  bf16x8 qf0[6];
  bf16* Qs = lds + 2 * ATT_BUF + wave * (32 * AK_LD);
  {
    const bf16* qrow = Qb + (size_t)(wave * 64 + r) * 96 + 8 * hh;
#pragma unroll
    for (int s = 0; s < 6; ++s) qf0[s] = *(const bf16x8*)(qrow + 16 * s);
    const bf16* qrow1 = qrow + (size_t)32 * 96;
#pragma unroll
    for (int s = 0; s < 6; ++s) *(bf16x8*)(Qs + r * AK_LD + 16 * s + 8 * hh) = *(const bf16x8*)(qrow1 + 16 * s);
  }
  f32x16 ot[2][2];
#pragma unroll
  for (int i = 0; i < 16; ++i) { ot[0][0][i] = 0.f; ot[0][1][i] = 0.f; ot[1][0][i] = 0.f; ot[1][1][i] = 0.f; }
  float m[2] = {0.f, 0.f}, lsum[2] = {0.f, 0.f};
  u32x4 rk[3], rv[2];
  const int vrow = tid >> 3, vcc = (tid & 7) * 8;
  const unsigned koff = (unsigned)tid * 8u, voff = (unsigned)(vrow * T + vcc);
#pragma unroll
  for (int i = 0; i < 3; ++i) rk[i] = *(const u32x4*)(Kb + (koff + 2048u * i));
#pragma unroll
  for (int i = 0; i < 2; ++i) rv[i] = *(const u32x4*)(Vb + (voff + (unsigned)(32 * T) * i));
  const int ntile = nk >> 6;
  for (int kt = 0; kt < ntile; ++kt) {
    bf16* Ks = lds + (kt & 1) * ATT_BUF;
    bf16* Vs = Ks + 64 * AK_LD;
#pragma unroll
    for (int i = 0; i < 3; ++i) { const int ci = tid + 256 * i; const int row = ci / 12, cc = ci % 12; *(u32x4*)(Ks + row * AK_LD + cc * 8) = rk[i]; }
#pragma unroll
    for (int i = 0; i < 2; ++i) {
      bf16* d = Vs + (vrow + 32 * i) * AV_LD + vcc;
      *(u32x2*)(d) = u32x2{rv[i][0], rv[i][1]}; *(u32x2*)(d + 4) = u32x2{rv[i][2], rv[i][3]};
    }
    __syncthreads();
    if (kt + 1 < ntile) {
      const bf16* kn = Kb + (size_t)(kt + 1) * 64 * 96;
      const bf16* vn = Vb + (kt + 1) * 64;
#pragma unroll
      for (int i = 0; i < 3; ++i) rk[i] = *(const u32x4*)(kn + (koff + 2048u * i));
#pragma unroll
      for (int i = 0; i < 2; ++i) rv[i] = *(const u32x4*)(vn + (voff + (unsigned)(32 * T) * i));
    }
#pragma unroll
    for (int qs = 0; qs < 2; ++qs) {
      __builtin_amdgcn_sched_barrier(0);
      f32x16 st[2];
      {
        f32x16 zz;
#pragma unroll
        for (int i = 0; i < 16; ++i) zz[i] = 0.f;
#pragma unroll
        for (int mt = 0; mt < 2; ++mt)
#pragma unroll
          for (int s = 0; s < 6; ++s) {
            const bf16x8 a = *(const bf16x8*)(Ks + (32 * mt + r) * AK_LD + 16 * s + 8 * hh);
            const bf16x8 qb_ = (qs == 0) ? qf0[s] : *(const bf16x8*)(Qs + r * AK_LD + 16 * s + 8 * hh);
            st[mt] = (s == 0) ? MFMA32(a, qb_, zz) : MFMA32(a, qb_, st[mt]);
          }
      }
      if (__builtin_amdgcn_ballot_w64(m[qs] != 0.f) != 0ull) {
#pragma unroll
        for (int i = 0; i < 16; ++i) { st[0][i] -= m[qs]; st[1][i] -= m[qs]; }
      }
      float mx = st[0][0];
#pragma unroll
      for (int i = 1; i < 16; ++i) mx = fmaxf(mx, st[0][i]);
#pragma unroll
      for (int i = 0; i < 16; ++i) mx = fmaxf(mx, st[1][i]);
      mx = xhalf_max(mx);
      if (__builtin_amdgcn_ballot_w64((kt == 0) ? (fabsf(mx) > 16.f) : (mx > 16.f)) != 0ull) {
        const float d = (kt == 0) ? mx : fmaxf(mx, 0.f);
        const float alpha = __builtin_amdgcn_exp2f(-d);
        m[qs] += d; lsum[qs] *= alpha;
#pragma unroll
        for (int i = 0; i < 16; ++i) { ot[qs][0][i] *= alpha; ot[qs][1][i] *= alpha; st[0][i] -= d; st[1][i] -= d; }
      }
      float ps = 0.f;
#pragma unroll
      for (int sp = 0; sp < 4; ++sp) {
        const int mt = sp >> 1, s2 = sp & 1;
        float e[8];
#pragma unroll
        for (int j = 0; j < 8; ++j) { e[j] = __builtin_amdgcn_exp2f(st[mt][8 * s2 + j]); ps += e[j]; }
        u32x4 pk;
        pk[0] = pk2(e[0], e[1]); pk[1] = pk2(e[2], e[3]); pk[2] = pk2(e[4], e[5]); pk[3] = pk2(e[6], e[7]);
        const bf16x8 pf = __builtin_bit_cast(bf16x8, pk);
#pragma unroll
        for (int vt = 0; vt < 2; ++vt) {
          const bf16* vp = Vs + (32 * vt + r) * AV_LD + 32 * mt + 16 * s2 + 4 * hh;
          const s16x4 lo = *(const s16x4*)(vp), hi = *(const s16x4*)(vp + 8);
          const bf16x8 a = __builtin_shufflevector(lo, hi, 0, 1, 2, 3, 4, 5, 6, 7);
          ot[qs][vt] = MFMA32(a, pf, ot[qs][vt]);
        }
      }
      lsum[qs] += ps;
    }
  }
  __syncthreads();
#pragma unroll
  for (int qs = 0; qs < 2; ++qs) {
    const float inv = 1.f / xhalf_sum(lsum[qs]);
    const int row = rowbase + wave * 64 + qs * 32 + r;
    const bf16* mg = c.P() + (size_t)row * LDP + C_MG + h * 64;
    bf16* dst = c.HY() + (size_t)row * D + 512 + h * 64;
#pragma unroll
    for (int vt = 0; vt < 2; ++vt)
#pragma unroll
      for (int g = 0; g < 4; ++g) {
        const int vd = 32 * vt + 8 * g + 4 * hh;
        const f32x4 g4 = unpk4(*(const u32x2*)(mg + vd));
        f32x4 o = {ot[qs][vt][4 * g] * inv * silu(g4[0]), ot[qs][vt][4 * g + 1] * inv * silu(g4[1]), ot[qs][vt][4 * g + 2] * inv * silu(g4[2]), ot[qs][vt][4 * g + 3] * inv * silu(g4[3])};
        *(u32x2*)(dst + vd) = pk4(o);
      }
  }
}

DI void row_rstd(const bf16* base, int ncols, float* rs) {
  const int tid = otid(), row = tid >> 1, half = tid & 1;
  const bf16* pp = base + (size_t)row * LDP + half * (ncols >> 1);
  float ss = 0.f;
  for (int i = 0; i < (ncols >> 4); ++i) {
    const u32x4 u = *(const u32x4*)(pp + i * 8);
#pragma unroll
    for (int j = 0; j < 4; ++j) { const float a = __uint_as_float(u[j] << 16), b = __uint_as_float(u[j] & 0xffff0000u); ss += a * a + b * b; }
  }
  ss += __shfl_xor(ss, 1);
  if (!half) rs[row] = rsqrtf(ss / (float)ncols + LN_EPS);
  __syncthreads();
}
struct RowPos { int b, pos; bool lat; };
DI RowPos row_pos(int m) { RowPos r; r.lat = m < MLAT; if (r.lat) { r.b = m >> 13; r.pos = m & 8191; } else { const int mc = m - MLAT; r.b = mc >> 8; r.pos = mc & 255; } return r; }

struct EpiQ { bf16* Q; bf16* QC; const float* rope; const float* rs; int m0;
  DI void operator()(int m, int n, f32x4 v) const {
    const float sc = rs[m - m0] * QSCALE;
    const int h = n / 96, j = n - h * 96;
    const RowPos rp = row_pos(m);
    bf16* dst = rp.lat ? Q + ((size_t)(rp.b * 8 + h) * S + rp.pos) * 96 + j : QC + ((size_t)(rp.b * 8 + h) * L + rp.pos) * 96 + j;
    f32x4 o;
    if (j < 64 || !rp.lat) { o = v * sc; }
    else {
      const float4 cs = *(const float4*)(rope + (rp.pos * 16 + ((j - 64) >> 1)) * 2);
      o[0] = (v[0] * cs.x - v[1] * cs.y) * sc; o[1] = (v[0] * cs.y + v[1] * cs.x) * sc;
      o[2] = (v[2] * cs.z - v[3] * cs.w) * sc; o[3] = (v[2] * cs.w + v[3] * cs.z) * sc;
    }
    *(u32x2*)dst = pk4(o);
  } };
struct EpiK { bf16* K; const float* rs; int m0;
  DI void operator()(int m, int n, f32x4 v) const {
    const RowPos rp = row_pos(m); const int pos = rp.lat ? L + rp.pos : rp.pos, h = n >> 6, j = n & 63;
    *(u32x2*)(K + ((size_t)(rp.b * 8 + h) * T + pos) * 96 + j) = pk4(v * rs[m - m0]);
  } };
struct EpiV { bf16* VT; const float* rs; int m0;
  DI void operator()(int m, int n, f32x4 v) const {
    const RowPos rp = row_pos(m); const int pos = rp.lat ? L + rp.pos : rp.pos, h = n >> 6, vd = n & 63;
    const float4 r4 = *(const float4*)(rs + (m - m0));
    f32x4 o = {v[0] * r4.x, v[1] * r4.y, v[2] * r4.z, v[3] * r4.w};
    *(u32x2*)(VT + ((size_t)(rp.b * 8 + h) * 64 + vd) * T + pos) = pk4(o);
  } };

constexpr int GL = 72;
DI int gla_row0(int b, int cm) { return cm < 128 ? b * S + cm * 64 : MLAT + b * L + (cm - 128) * 64; }
DI void gla_gates(const Ctx& c, int li, const bf16* LR, int h, int dir, float (&bv)[16], float& bmid, float& bend, float* sred) {
  const Params& p = c.p;
  const int tid = otid(), k = tid & 63, tq = tid >> 6;
  float w2r[16];
#pragma unroll
  for (int r = 0; r < 16; ++r) w2r[r] = p.gla_w2[((size_t)(li * 2 + dir) * 16 + r) * 256 + h * 64 + k];
  const float bias = p.gla_b[(li * 2 + dir) * 256 + h * 64 + k];
#pragma unroll
  for (int i = 0; i < 16; ++i) {
    const bf16* lr = LR + (16 * tq + i) * 32 + dir * 16;
    const u32x4 u0 = *(const u32x4*)lr, u1 = *(const u32x4*)(lr + 8);
    float z = bias;
#pragma unroll
    for (int j = 0; j < 4; ++j) {
      z += __uint_as_float(u0[j] << 16) * w2r[2 * j] + __uint_as_float(u0[j] & 0xffff0000u) * w2r[2 * j + 1];
      z += __uint_as_float(u1[j] << 16) * w2r[8 + 2 * j] + __uint_as_float(u1[j] & 0xffff0000u) * w2r[8 + 2 * j + 1];
    }
    bv[i] = logsigmoid_fast(z) * (1.f / 16.f);
  }
  if (dir == 0) {
#pragma unroll
    for (int i = 1; i < 16; ++i) bv[i] += bv[i - 1];
    sred[tq * 64 + k] = bv[15];
  } else {
#pragma unroll
    for (int i = 14; i >= 0; --i) bv[i] += bv[i + 1];
    sred[tq * 64 + k] = bv[0];
  }
  __syncthreads();
  const float s0 = sred[k], s1 = sred[64 + k], s2 = sred[128 + k], s3 = sred[192 + k];
  bend = s0 + s1 + s2 + s3;
  float off;
  if (dir == 0) { off = (tq > 0 ? s0 : 0.f) + (tq > 1 ? s1 : 0.f) + (tq > 2 ? s2 : 0.f); bmid = s0 + s1; }
  else { off = (tq < 3 ? s3 : 0.f) + (tq < 2 ? s2 : 0.f) + (tq < 1 ? s1 : 0.f); bmid = s2 + s3; }
#pragma unroll
  for (int i = 0; i < 16; ++i) bv[i] += off;
  __syncthreads();
}
constexpr int GVR = 136;
DI void gla_stage64(const bf16* src, bf16* dst) {
  const int tid = otid();
#pragma unroll
  for (int i = 0; i < 2; ++i) { const int ci = tid + 256 * i, t = ci >> 3, cc = (ci & 7) * 8; *(u32x4*)(dst + t * GL + cc) = *(const u32x4*)(src + (size_t)t * LDP + cc); }
}
DI void gla_stage_v_lr(const Ctx& c, int row0, int h, bf16* Vraw, bf16* LR) {
  const int tid = otid();
  const bf16* src = c.P() + (size_t)row0 * LDP + C_GV + h * 128;
#pragma unroll
  for (int i = 0; i < 4; ++i) { const int ci = tid + 256 * i, t = ci >> 4, cc = (ci & 15) * 8; *(u32x4*)(Vraw + t * GVR + cc) = *(const u32x4*)(src + (size_t)t * LDP + cc); }
  { const int t = tid >> 2, cc = (tid & 3) * 8; *(u32x4*)(LR + t * 32 + cc) = *(const u32x4*)(c.P() + (size_t)(row0 + t) * LDP + C_GLR + cc); }
}
DI void gla_transpose_v(const bf16* Vraw, bf16* VTs) {
  const int tid = otid(), v = tid & 127, half = tid >> 7;
#pragma unroll
  for (int i = 0; i < 4; ++i) {
    u32x4 w;
#pragma unroll
    for (int j = 0; j < 4; ++j) w[j] = (unsigned)Vraw[(32 * half + 8 * i + 2 * j) * GVR + v] | ((unsigned)Vraw[(32 * half + 8 * i + 2 * j + 1) * GVR + v] << 16);
    *(u32x4*)(VTs + v * GL + 32 * half + 8 * i) = w;
  }
}
DI bf16x8 ldfrag(const bf16* tile, int row, int kk, int lq) { return *(const bf16x8*)(tile + row * GL + kk * 32 + lq * 8); }
#define MFMA16(a, b, c) __builtin_amdgcn_mfma_f32_16x16x32_bf16((a), (b), (c), 0, 0, 0)

DI void gla_g1_item(const Ctx& c, int l, int item, bf16* lds) {
  const int li = l >> 1;
  const int tid = otid(), lane = tid & 63, wave = tid >> 6, l16 = lane & 15, lq = lane >> 4, k = tid & 63, tq = tid >> 6;
  const int cm = item % 132, bh = item / 132, h = bh & 3, b = bh >> 2;
  const int row0 = gla_row0(b, cm);
  bf16* VTs = lds; bf16* KBT = lds + 9216; float* sred = (float*)(lds + 13824); bf16* LR = lds + 14336; bf16* Kraw = lds + 16384; bf16* Vraw = lds + 20992;
  gla_stage64(c.P() + (size_t)row0 * LDP + C_GK + h * 64, Kraw);
  gla_stage_v_lr(c, row0, h, Vraw, LR);
  __syncthreads();
  float kreg[16];
#pragma unroll
  for (int i = 0; i < 16; ++i) kreg[i] = bf2f(Kraw[(16 * tq + i) * GL + k]);
  gla_transpose_v(Vraw, VTs);
  for (int dir = 0; dir < 2; ++dir) {
    float bv[16], bmid, bend;
    gla_gates(c, li, LR, h, dir, bv, bmid, bend, sred);
    u32x4 w0, w1;
    {
      float kv[16];
#pragma unroll
      for (int i = 0; i < 16; ++i) kv[i] = kreg[i] * __expf(bend - bv[i]);
#pragma unroll
      for (int j = 0; j < 4; ++j) { w0[j] = pk2(kv[2 * j], kv[2 * j + 1]); w1[j] = pk2(kv[8 + 2 * j], kv[8 + 2 * j + 1]); }
    }
    *(u32x4*)(KBT + k * GL + 16 * tq) = w0; *(u32x4*)(KBT + k * GL + 16 * tq + 8) = w1;
    const size_t sidx = ((size_t)((b * 2 + dir) * 132 + cm) * 4 + h);
    if (tq == 0) c.DEC()[sidx * 64 + k] = __expf(bend);
    __syncthreads();
    f32x4 acc[2][4];
#pragma unroll
    for (int i = 0; i < 2; ++i)
#pragma unroll
      for (int j = 0; j < 4; ++j) acc[i][j] = f32x4{0.f, 0.f, 0.f, 0.f};
#pragma unroll
    for (int kk = 0; kk < 2; ++kk) {
      bf16x8 af[2], bfr[4];
#pragma unroll
      for (int i = 0; i < 2; ++i) af[i] = ldfrag(VTs, 32 * wave + 16 * i + l16, kk, lq);
#pragma unroll
      for (int j = 0; j < 4; ++j) bfr[j] = ldfrag(KBT, 16 * j + l16, kk, lq);
#pragma unroll
      for (int i = 0; i < 2; ++i)
#pragma unroll
        for (int j = 0; j < 4; ++j) acc[i][j] = MFMA16(bfr[j], af[i], acc[i][j]);
    }
    bf16* dsp = c.G() + sidx * 8192;
#pragma unroll
    for (int i = 0; i < 2; ++i)
#pragma unroll
      for (int j = 0; j < 4; ++j) *(u32x2*)(dsp + (32 * wave + 16 * i + l16) * 64 + 16 * j + 4 * lq) = pk4(acc[i][j]);
    __syncthreads();
  }
}

DI void gla_g2(const Ctx& c) {
  const int gt = blockIdx.x * NT + otid(), gs = gridDim.x * NT;
  for (int i = gt; i < 16 * 8192; i += gs) {
    const int e = i & 8191, kk = e & 63, q = i >> 13, h = q & 3, bd = q >> 2, dir = bd & 1;
    float st = 0.f;
    for (int c0 = 0; c0 < 132; c0 += 12) {
      float dsv[12], dec[12]; bf16* pd[12];
#pragma unroll
      for (int j = 0; j < 12; ++j) {
        const int ci = c0 + j;
        const int cm = dir ? (131 - ci) : (ci < 4 ? 128 + ci : ci - 4);
        const size_t sidx = (size_t)(bd * 132 + cm) * 4 + h;
        pd[j] = c.G() + sidx * 8192 + e;
        dsv[j] = bf2f(*pd[j]); dec[j] = c.DEC()[sidx * 64 + kk];
      }
#pragma unroll
      for (int j = 0; j < 12; ++j) { *pd[j] = f2bf(st); st = dec[j] * st + dsv[j]; }
    }
  }
}

DI void gla_g3_item(const Ctx& c, int l, int item, bf16* lds) {
  const Params& p = c.p; const int li = l >> 1;
  const int tid = otid(), lane = tid & 63, wave = tid >> 6, l16 = lane & 15, lq = lane >> 4, k = tid & 63, tq = tid >> 6;
  const int ncm = (l == 0) ? 132 : 128;
  const int cm = item % ncm, bh = item / ncm, h = bh & 3, b = bh >> 2;
  const int row0 = gla_row0(b, cm);
  bf16* X1 = lds; bf16* X2 = lds + 64 * GL; bf16* VTs = lds + 128 * GL; bf16* STs = lds + 256 * GL; float* sred = (float*)(lds + 384 * GL);
  bf16* LR = lds + 384 * GL + 512;
  gla_stage64(c.P() + (size_t)row0 * LDP + C_GQ + h * 64, X1);
  gla_stage64(c.P() + (size_t)row0 * LDP + C_GK + h * 64, X2);
  gla_stage_v_lr(c, row0, h, STs, LR);
  __syncthreads();
  float qreg[16], kreg[16];
#pragma unroll
  for (int i = 0; i < 16; ++i) { qreg[i] = bf2f(X1[(16 * tq + i) * GL + k]) * 0.125f; kreg[i] = bf2f(X2[(16 * tq + i) * GL + k]); }
  gla_transpose_v(STs, VTs);
  __syncthreads();
  f32x4 o[8];
#pragma unroll
  for (int j = 0; j < 8; ++j) o[j] = f32x4{0.f, 0.f, 0.f, 0.f};
  for (int dir = 0; dir < 2; ++dir) {
    u32x4 stg[4];
    {
      const bf16* sp = c.G() + ((size_t)((b * 2 + dir) * 132 + cm) * 4 + h) * 8192;
#pragma unroll
      for (int i = 0; i < 4; ++i) { const int ci = tid + 256 * i; stg[i] = *(const u32x4*)(sp + (ci >> 3) * 64 + (ci & 7) * 8); }
    }
    float bv[16], bmid, bend;
    gla_gates(c, li, LR, h, dir, bv, bmid, bend, sred);
    float qb[16];
#pragma unroll
    for (int i = 0; i < 16; ++i) {
      X1[(16 * tq + i) * GL + k] = f2bf(qreg[i] * __expf(bv[i] - bmid));
      X2[(16 * tq + i) * GL + k] = f2bf(kreg[i] * __expf(bmid - bv[i]));
      qb[i] = qreg[i] * __expf(bv[i]);
    }
    __syncthreads();
    f32x4 att[4];
#pragma unroll
    for (int j = 0; j < 4; ++j) att[j] = f32x4{0.f, 0.f, 0.f, 0.f};
#pragma unroll
    for (int kk = 0; kk < 2; ++kk) {
      const bf16x8 af = ldfrag(X1, 16 * wave + l16, kk, lq);
#pragma unroll
      for (int j = 0; j < 4; ++j) att[j] = MFMA16(ldfrag(X2, 16 * j + l16, kk, lq), af, att[j]);
    }
    __syncthreads();
    {
      const int t = 16 * wave + l16;
#pragma unroll
      for (int j = 0; j < 4; ++j) {
        f32x4 a = att[j];
#pragma unroll
        for (int r = 0; r < 4; ++r) { const int s_ = 16 * j + 4 * lq + r; if (dir == 0 ? (s_ > t) : (s_ < t)) a[r] = 0.f; }
        *(u32x2*)(X1 + t * GL + 16 * j + 4 * lq) = pk4(a);
      }
#pragma unroll
      for (int i = 0; i < 16; ++i) X2[(16 * tq + i) * GL + k] = f2bf(qb[i]);
#pragma unroll
      for (int i = 0; i < 4; ++i) { const int ci = tid + 256 * i; *(u32x4*)(STs + (ci >> 3) * GL + (ci & 7) * 8) = stg[i]; }
    }
    __syncthreads();
#pragma unroll
    for (int kk = 0; kk < 2; ++kk) {
      const bf16x8 a1 = ldfrag(X1, 16 * wave + l16, kk, lq), a2 = ldfrag(X2, 16 * wave + l16, kk, lq);
#pragma unroll
      for (int j = 0; j < 8; ++j) {
        o[j] = MFMA16(ldfrag(VTs, 16 * j + l16, kk, lq), a1, o[j]);
        o[j] = MFMA16(ldfrag(STs, 16 * j + l16, kk, lq), a2, o[j]);
      }
    }
    __syncthreads();
  }
  float ss = 0.f;
#pragma unroll
  for (int j = 0; j < 8; ++j)
#pragma unroll
    for (int r = 0; r < 4; ++r) ss += o[j][r] * o[j][r];
  ss += __shfl_xor(ss, 16); ss += __shfl_xor(ss, 32);
  const float rstd = rsqrtf(ss * (1.f / 128.f) + LN_EPS);
  const int row = row0 + 16 * wave + l16;
  const bf16* gg = c.P() + (size_t)row * LDP + C_GG + h * 128;
  bf16* dst = c.HY() + (size_t)row * D + h * 128;
#pragma unroll
  for (int j = 0; j < 8; ++j) {
    const int v = 16 * j + 4 * lq;
    const float4 gn = *(const float4*)(p.gla_norm_g + li * 128 + v);
    const f32x4 g4 = unpk4(*(const u32x2*)(gg + v));
    f32x4 y = {o[j][0] * rstd * gn.x * silu(g4[0]), o[j][1] * rstd * gn.y * silu(g4[1]), o[j][2] * rstd * gn.z * silu(g4[2]), o[j][3] * rstd * gn.w * silu(g4[3])};
    *(u32x2*)(dst + v) = pk4(y);
  }
}

DI void phase_even_b(const Ctx& c, int l, bf16* lds) {
  float* rs = (float*)(lds + GEMM_LDS_BF16);
  const int qrows = (l == 0) ? MT : MLAT;
  const int n_q = (qrows / 128) * 6, n_k = 132 * 4, n_v = 132 * 4, n_g1 = 8 * 132;
  const int total = n_q + n_k + n_v + n_g1;
  for (int it0 = blockIdx.x; it0 < total; it0 += gridDim.x) {
    const int it = (it0 < n_g1) ? (n_q + n_k + n_v + it0) : (it0 - n_g1);
    if (it < n_q) {
      const int m0 = (it / 6) * 128, n0 = (it % 6) * 128;
      row_rstd(c.P() + (size_t)m0 * LDP + C_CQ, 256, rs);
      mfma_gemm_tile<0>(RowPtr{c.P() + C_CQ, LDP}, RowPtr{c.WL() + WL_UQ / 2, 256}, m0, n0, 256, EpiQ{c.Q(), c.QC(), c.TAB() + TB_ROPE, rs, m0}, lds);
    } else if (it < n_q + n_k) {
      const int q = it - n_q, m0 = (q >> 2) * 128, n0 = (q & 3) * 128;
      row_rstd(c.P() + (size_t)m0 * LDP + C_CKV, 128, rs);
      mfma_gemm_tile<0>(RowPtr{c.P() + C_CKV, LDP}, RowPtr{c.WL() + WL_UKV / 2, 128}, m0, n0, 128, EpiK{c.K(), rs, m0}, lds);
    } else if (it < n_q + n_k + n_v) {
      const int q = it - n_q - n_k, m0 = (q >> 2) * 128, n0 = (q & 3) * 128;
      row_rstd(c.P() + (size_t)m0 * LDP + C_CKV, 128, rs);
      mfma_gemm_tile<1>(RowPtr{c.P() + C_CKV, LDP}, RowPtr{c.WL() + WL_UKV / 2 + (size_t)512 * 128, 128}, m0, n0, 128, EpiV{c.VT(), rs, m0}, lds);
    } else gla_g1_item(c, l, it - n_q - n_k - n_v, lds);
  }
  const size_t gt = (size_t)blockIdx.x * NT + otid(), gs = (size_t)gridDim.x * NT;
  for (size_t i = gt; i < (size_t)MT * 16; i += gs) {
    const int row = (int)(i >> 4), f = (int)(i & 15);
    const bf16* kr = c.P() + (size_t)row * LDP + C_KR;
    const float x1 = bf2f(kr[f]), x2 = bf2f(kr[16 + f]);
    const RowPos rp = row_pos(row); const int pos = rp.lat ? L + rp.pos : rp.pos;
    float cs = 1.f, sn = 0.f;
    if (rp.lat) { cs = c.TAB()[TB_ROPE + (rp.pos * 16 + f) * 2]; sn = c.TAB()[TB_ROPE + (rp.pos * 16 + f) * 2 + 1]; }
    const unsigned o = pk2(x1 * cs - x2 * sn, x1 * sn + x2 * cs);
    for (int h = 0; h < 8; ++h) *(unsigned*)(c.K() + ((size_t)(rp.b * 8 + h) * T + pos) * 96 + 64 + 2 * f) = o;
  }
}
DI void phase_even_c(const Ctx& c, int l, bf16* lds) {
  gla_g2(c);
  xcd_items(512, [&](int it) { attn_item(c, it, lds); });
}
DI void phase_even_d(const Ctx& c, int l, bf16* lds) {
  const int n_ctx = (l == 0 ? 16 : 0), n_g3 = 8 * ((l == 0) ? 132 : 128);
  for (int it = blockIdx.x; it < n_ctx + n_g3; it += gridDim.x) {
    if (it < n_ctx) attn_item(c, 512 + it, lds);
    else gla_g3_item(c, l, it - n_ctx, lds);
  }
}


struct APChanLat { const bf16* P; int g; DI const bf16* operator()(int m) const { const int b = m >> 13, t2 = (m >> 6) & 127, t1 = m & 63; return P + (size_t)((b << 13) + 128 * t1 + t2) * LDP + C_F + g * 128; } };
struct EpiChanLat { bf16* ZT; int g; DI void operator()(int m, int n, f32x4 v) const {
  const int b = m >> 13, t2 = (m >> 6) & 127, t1 = m & 63, ri = n >> 7, j = n & 127;
  *(u32x2*)(ZT + ((size_t)((b * 512 + g * 128 + j) * 128 + t2)) * 128 + ri * 64 + t1) = pk4(v); } };
struct EpiChanCtx { bf16* ZTC; int g; DI void operator()(int m, int n, f32x4 v) const {
  const int b = m >> 8, t = m & 255, ri = n >> 7, j = n & 127;
  *(u32x2*)(ZTC + (size_t)(b * 512 + g * 128 + j) * 512 + ri * 256 + t) = pk4(v); } };

DI void vgt_tile(const Ctx& c, int ti, bf16* lds) {
  const int tid = otid(), lane = tid & 63, wave = tid >> 6;
  const int row0 = (ti >> 2) * 128, g = ti & 3;
  constexpr int LDT = 136;
  for (int rr = 0; rr < 32; ++rr) {
    const int t = wave * 32 + rr;
    const unsigned u = *(const unsigned*)(c.P() + (size_t)(row0 + t) * LDP + C_V + g * 128 + 2 * lane);
    const float a = gelu(__uint_as_float(u << 16)), b = gelu(__uint_as_float(u & 0xffff0000u));
    const float mean = wave_sum(a + b) * (1.f / 128.f);
    const float da = a - mean, db = b - mean;
    const float rstd = rsqrtf(wave_sum(da * da + db * db) * (1.f / 128.f) + LN_EPS);
    lds[(2 * lane) * LDT + t] = f2bf(da * rstd);
    lds[(2 * lane + 1) * LDT + t] = f2bf(db * rstd);
  }
  __syncthreads();
  {
    const int d = tid >> 1, half = tid & 1;
    bf16* dst = c.VGT() + ((size_t)ti * 128 + d) * 128 + half * 64;
    const bf16* src = lds + d * LDT + half * 64;
#pragma unroll
    for (int i = 0; i < 8; ++i) *(u32x4*)(dst + i * 8) = *(const u32x4*)(src + i * 8);
  }
  __syncthreads();
}

DI void phase_odd_a(const Ctx& c, int l, bf16* lds) {
  const int ntile_sgu = (l == 1) ? 528 : 512;
  const int n_lat = 4 * 128 * 2, n_ctx = (l == 1) ? 4 * 4 * 2 : 0;
  const bf16* cs128 = (const bf16*)((const unsigned char*)c.TAB() + TBB_CS128);
  const int total = ntile_sgu + n_lat + n_ctx;
  for (int it = blockIdx.x; it < total; it += gridDim.x) {
    if (it < ntile_sgu) vgt_tile(c, it, lds);
    else if (it < ntile_sgu + n_lat) {
      const int q = it - ntile_sgu, g = q >> 8, mt = (q >> 1) & 127, nt = q & 1;
      mfma_gemm_tile<1>(APChanLat{c.P(), g}, RowPtr{cs128, 128}, mt * 128, nt * 128, 128, EpiChanLat{c.ZT(), g}, lds);
    } else {
      const int q = it - ntile_sgu - n_lat, g = q >> 3, mt = (q >> 1) & 3, nt = q & 1;
      mfma_gemm_tile<1>(RowPtr{c.P() + (size_t)MLAT * LDP + C_F + g * 128, LDP}, RowPtr{cs128, 128}, mt * 128, nt * 128, 128, EpiChanCtx{c.ZTC(), g}, lds);
    }
  }
}

struct EpiStage1 { bf16* UT; DI void operator()(int m, int n, f32x4 v) const {
  const int b = m >> 16, col = (m >> 7) & 511, t2 = m & 127, ro = n >> 6, k1 = n & 63;
  *(u32x2*)(UT + ((size_t)((b * 64 + k1) * 512 + col)) * 256 + ro * 128 + t2) = pk4(v); } };
struct EpiSgu { const bf16* P; bf16* HY; const float* bias; int row0, g; DI void operator()(int m, int n, f32x4 v) const {
  const int row = row0 + m; const float bs = bias[m];
  const bf16* pr = P + (size_t)row * LDP + g * 128 + n;
  const f32x4 u = unpk4(*(const u32x2*)(pr + C_U)), sg = unpk4(*(const u32x2*)(pr + C_SG));
  f32x4 o;
#pragma unroll
  for (int i = 0; i < 4; ++i) o[i] = gelu(u[i]) * (v[i] + bs) * silu(sg[i]);
  *(u32x2*)(HY + (size_t)row * D + 512 + g * 128 + n) = pk4(o); } };
struct EpiCtxDft { const bf16* P; bf16* HY; DI void operator()(int m, int n, f32x4 v) const {
  const int b = m >> 9, col = m & 511, row = MLAT + b * 256 + n;
  const f32x4 fg = unpk4(*(const u32x2*)(P + (size_t)row * LDP + C_FG + col));
  f32x4 o;
#pragma unroll
  for (int i = 0; i < 4; ++i) o[i] = v[i] * 5.5242717280199e-3f * silu(fg[i]);
  *(u32x2*)(HY + (size_t)row * D + col) = pk4(o); } };

DI void phase_odd_b(const Ctx& c, int l, bf16* lds) {
  const Params& p = c.p; const int li = l >> 1;
  const int n_s1 = 1024, n_sgu = (l == 1) ? 528 : 512, n_ctx = (l == 1) ? 16 : 0;
  const bf16* w1 = (const bf16*)((const unsigned char*)c.TAB() + TBB_W1);
  const bf16* w256 = (const bf16*)((const unsigned char*)c.TAB() + TBB_W256);
  const int total = n_s1 + n_sgu + n_ctx;
  for (int it0 = blockIdx.x; it0 < total; it0 += gridDim.x) {
    const int it = (it0 < n_ctx) ? (n_s1 + n_sgu + it0) : (it0 < n_ctx + n_sgu ? n_s1 + (it0 - n_ctx) : it0 - n_ctx - n_sgu);
    if (it < n_s1) mfma_gemm_tile<1>(RowPtr{c.ZT(), 128}, RowPtr{w1, 128}, it * 128, 0, 128, EpiStage1{c.UT()}, lds);
    else if (it < n_s1 + n_sgu) {
      const int ti = it - n_s1, g = ti & 3, row0 = (ti >> 2) * 128;
      mfma_gemm_tile<0>(RowPtr{c.WL() + WL_SGU / 2 + (size_t)g * 128 * 128, 128}, RowPtr{c.VGT() + (size_t)ti * 128 * 128, 128}, 0, 0, 128,
                        EpiSgu{c.P(), c.HY(), p.sgu_b + (li * 4 + g) * 128, row0, g}, lds);
    } else {
      const int q = it - n_s1 - n_sgu;
      mfma_gemm_tile<1>(RowPtr{c.ZTC(), 512}, RowPtr{w256, 512}, (q >> 1) * 128, (q & 1) * 128, 512, EpiCtxDft{c.P(), c.HY()}, lds);
    }
  }
}

struct BPStage2 { const bf16* W2F; int k1; DI const bf16* operator()(int n) const { return W2F + (size_t)(k1 + 64 * n) * 256; } };
struct EpiStage2 { const bf16* P; bf16* HY; int b, k1; DI void operator()(int m, int n, f32x4 v) const {
  const int row = b * S + k1 + 64 * n;
  const f32x4 fg = unpk4(*(const u32x2*)(P + (size_t)row * LDP + C_FG + m));
  f32x4 o;
#pragma unroll
  for (int i = 0; i < 4; ++i) o[i] = v[i] * 9.765625e-4f * silu(fg[i]);
  *(u32x2*)(HY + (size_t)row * D + m) = pk4(o); } };

DI void phase_odd_c(const Ctx& c, bf16* lds) {
  for (int it = blockIdx.x; it < 512; it += gridDim.x) {
    const int bk = it >> 2, b = bk >> 6, k1 = bk & 63, mt = it & 3;
    mfma_gemm_tile<1>(RowPtr{c.UT() + (size_t)bk * 512 * 256, 256}, BPStage2{c.WL() + WL_W2F / 2, k1}, mt * 128, 0, 256, EpiStage2{c.P(), c.HY(), b, k1}, lds);
  }
}


#define LAS __attribute__((address_space(3)))
#define XB_TMO      128
#define XB_XCNT(j)  (256  + 64 * (j))
#define XB_XSUB(j)  (1280 + 64 * (j))
#define XB_XGEN(j)  (2304 + 64 * (j))
#define XB_TOP      3328
#define XB_TOPGEN   3392
#define XCD_BAR_WORDS 3456
#define XB_SPIN_CAP (1u << 22)
DI unsigned xb_ld(unsigned* p) { return __hip_atomic_load(p, __ATOMIC_RELAXED, __HIP_MEMORY_SCOPE_AGENT); }
DI unsigned xb_add(unsigned* p, unsigned v) { return __hip_atomic_fetch_add(p, v, __ATOMIC_RELAXED, __HIP_MEMORY_SCOPE_AGENT); }
DI unsigned xb_xcc_id() { return (unsigned)__builtin_amdgcn_s_getreg((3 << 11) | 20) & 0xFu; }
#define XB_SPIN(cond, bar) do { unsigned _sp = 0; while (cond) { __builtin_amdgcn_s_sleep(1); \
    if ((++_sp & 255u) == 0u) { if (xb_ld(&(bar)[XB_TMO])) break; if (_sp > XB_SPIN_CAP) { atomicAdd(&(bar)[XB_TMO], 1u); break; } } } } while (0)
struct XcdBarrier { unsigned* bar; unsigned x; volatile unsigned* st; };
DI XcdBarrier xcd_barrier_post(unsigned* bar, volatile unsigned* st) {
  XcdBarrier b; b.bar = bar; b.x = xb_xcc_id(); b.st = st;
  if (threadIdx.x == 0) (void)xb_add(&bar[XB_XCNT(b.x)], 1u);
  return b;
}
DI void xcd_barrier_complete(unsigned* bar, unsigned x, unsigned& nloc, unsigned& nx) {
  const unsigned G = gridDim.x * gridDim.y * gridDim.z;
  unsigned sum, cnt, mine, sp = 0u;
  for (;;) {
    sum = 0u; cnt = 0u; mine = 0u;
#pragma unroll
    for (unsigned j = 0; j < 16; ++j) { const unsigned cc = xb_ld(&bar[XB_XCNT(j)]); sum += cc; cnt += (cc > 0u) ? 1u : 0u; mine = (j == x) ? cc : mine; }
    if (sum == G) break;
    __builtin_amdgcn_s_sleep(1);
    if ((++sp & 255u) == 0u) { if (xb_ld(&bar[XB_TMO])) break; if (sp > XB_SPIN_CAP) { atomicAdd(&bar[XB_TMO], 1u); break; } }
  }
  nloc = mine > 0u ? mine : 1u; nx = cnt > 0u ? cnt : 1u;
}
DI void xcd_barrier(const XcdBarrier& b) {
  asm volatile("s_waitcnt vmcnt(0)" ::: "memory");
  __syncthreads();
  if (threadIdx.x == 0) {
    unsigned* bar = b.bar;
    __builtin_amdgcn_s_waitcnt(0);
    unsigned nloc = b.st[0], nx = b.st[1];
    if (nloc == 0u) { xcd_barrier_complete(bar, b.x, nloc, nx); b.st[0] = nloc; b.st[1] = nx; }
    const unsigned old = xb_add(&bar[XB_XSUB(b.x)], 1u);
    const unsigned gen = old / nloc;
    if (old + 1u == (gen + 1u) * nloc) {
      __builtin_amdgcn_fence(__ATOMIC_RELEASE, "agent");
      asm volatile("s_waitcnt vmcnt(0)" ::: "memory");
      const unsigned og = xb_add(&bar[XB_TOP], 1u);
      const unsigned tg = og / nx;
      if (og + 1u == (tg + 1u) * nx) xb_add(&bar[XB_TOPGEN], 1u);
      else XB_SPIN(xb_ld(&bar[XB_TOPGEN]) == tg, bar);
      __builtin_amdgcn_fence(__ATOMIC_ACQUIRE, "agent");
      xb_add(&bar[XB_XGEN(b.x)], 1u);
      asm volatile("s_waitcnt vmcnt(0)" ::: "memory");
    } else {
      XB_SPIN(xb_ld(&bar[XB_XGEN(b.x)]) == gen, bar);
      __builtin_amdgcn_fence(__ATOMIC_ACQUIRE, "agent");
      asm volatile("s_waitcnt vmcnt(0)" ::: "memory");
    }
  }
  __syncthreads();
}

__global__ void __launch_bounds__(NT, 2) fwd_kernel(Params p) {
  cg::grid_group grid = cg::this_grid();
  __shared__ __attribute__((aligned(16))) bf16 lds[GEMM_LDS_BF16 + 256];
  float* sm = (float*)lds;
  unsigned char* ws = p.ws;
  Ctx c{p, sm};
  __shared__ unsigned bar_st[2];
  if (threadIdx.x == 0) { bar_st[0] = 0u; bar_st[1] = 0u; }
  __syncthreads();
  (void)xcd_barrier_post((unsigned*)(ws + WS_BAR), bar_st);
#define SYNC() do { XcdBarrier b_; b_.bar = (unsigned*)(p.ws + WS_BAR); b_.x = xb_xcc_id(); b_.st = bar_st; xcd_barrier(b_); } while (0)
  phase_prologue(c, 0, 192, false);
  SYNC();
  if (p.out == nullptr) grid.sync();
  phase_ln(c, -1, 0);
  phase_prologue(c, 192, 768, true);
  phase_wconv_in(c, 0);
  SYNC();
  for (int l = 0; l < 4; ++l) {
    const int li = l >> 1;
    const int rows_in = (l <= 2) ? MT : MLAT, rows_out = (l <= 1) ? MT : MLAT;
    phase_wconv_rest(c, l);
    if ((l & 1) == 0) {
      mfma_gemm_big(RowPtr{c.HY(), D}, RowPtr{c.WL() + WL_IN / 2, D}, rows_in, 2560, D, EpiStoreP4{c.P()}, lds);
      SYNC();
      if (PROBE & 1) { mfma_gemm_big(RowPtr{c.HY(), D}, RowPtr{c.WL() + WL_IN / 2, D}, rows_in, 2560, D, EpiStoreP4{c.P()}, lds); SYNC(); }
      phase_even_b(c, l, lds);
      SYNC();
      if (PROBE & 4) { phase_even_b(c, l, lds); SYNC(); }
      phase_even_c(c, l, lds);
      SYNC();
      phase_even_d(c, l, lds);
      SYNC();
      if (PROBE & 4) { phase_even_d(c, l, lds); SYNC(); }
    } else {
      mfma_gemm_big(RowPtr{c.HY(), D}, RowPtr{c.WL() + WL_IN / 2, D}, rows_in, 2560, D, EpiStoreP4{c.P()}, lds);
      SYNC();
      if (PROBE & 1) { mfma_gemm_big(RowPtr{c.HY(), D}, RowPtr{c.WL() + WL_IN / 2, D}, rows_in, 2560, D, EpiStoreP4{c.P()}, lds); SYNC(); }
      phase_odd_a(c, l, lds);
      SYNC();
      if (PROBE & 8) { phase_odd_a(c, l, lds); SYNC(); }
      phase_odd_b(c, l, lds);
      SYNC();
      if (PROBE & 8) { phase_odd_b(c, l, lds); SYNC(); }
      phase_odd_c(c, lds);
      SYNC();
      if (PROBE & 8) { phase_odd_c(c, lds); SYNC(); }
    }
    if (l < 3) phase_wconv_in(c, l + 1);
    mfma_gemm_big(RowPtr{c.HY(), D}, RowPtr{c.WL() + WL_OUT / 2, D}, MLAT, D, D, EpiResid4{p.x, p.ctx, p.out, c.XC(), c.MOD(), l}, lds);
    if (rows_out > MLAT)
      for (int t = blockIdx.x; t < 32; t += gridDim.x)
        mfma_gemm_tile<0>(RowPtr{c.HY(), D}, RowPtr{c.WL() + WL_OUT / 2, D}, MLAT + (t >> 3) * 128, (t & 7) * 128, D, EpiResid4{p.x, p.ctx, p.out, c.XC(), c.MOD(), l}, lds);
    SYNC();
    phase_ln(c, l, l < 3 ? l + 1 : -1);
    if (l < 3) SYNC();
  }
}

extern "C" void kernel_launch(void* const* d_in, const int* in_sizes, int n_in, void* d_out, int out_size, void* d_ws, size_t ws_size,
                              hipStream_t stream) {
  static int grid_blocks = 0;
  if (!grid_blocks) {
    int dev = 0, cus = 0, per_cu = 0;
    hipGetDevice(&dev);
    hipDeviceGetAttribute(&cus, hipDeviceAttributeMultiprocessorCount, dev);
    hipOccupancyMaxActiveBlocksPerMultiprocessor(&per_cu, fwd_kernel, NT, 0);
    if (per_cu < 1) per_cu = 1;
    if (per_cu > 2) per_cu = 2;
    grid_blocks = cus * per_cu;
    if (ws_size < WS_END) fprintf(stderr, "kernel_launch: workspace too small: %zu < %zu\n", ws_size, (size_t)WS_END);
  }
  (void)hipMemsetAsync((unsigned char*)d_ws + WS_BAR, 0, WS_XC - WS_BAR, stream);
  Params p{};
  const float** pp = (const float**)&p;
  for (int i = 0; i < 21; ++i) pp[i] = (const float*)d_in[i];
  p.out = (float*)d_out; p.ws = (unsigned char*)d_ws;
  void* args[] = {&p};
  hipError_t e = hipLaunchCooperativeKernel((void*)fwd_kernel, dim3(grid_blocks), dim3(NT), args, 0, stream);
  if (e != hipSuccess) fprintf(stderr, "cooperative launch failed: %s (grid %d)\n", hipGetErrorString(e), grid_blocks);
}
```
